# Optimizing an MI355X kernel written in HIP

```python
import math
import jax
import jax.numpy as jnp
from jax import lax
import numpy as np

D_MODEL = 1024
BATCH = 32
SEQ = 256
DEPTH = 2
DEC_BATCH = 8
DEC_SEQ = 2048
PAST_LEN = 256

GRID_W = 64
Q_BLOCK = 128
HEAD_DIM = 64
GA_HEADS = 8
GA_KV_HEADS = 2
NA_HEADS = 8
NA_WIN_ROWS = 8
NA_WIN_COLS = 16
SSM_WIDTH = 512
SSM_GROUP_CH = 16
SSM_GROUPS = SSM_WIDTH // SSM_GROUP_CH
SSM_STATE = 64
D_FF = 2816
N_BRANCH = 3
ROPE_THETA = 10000.0
EPS = 1e-6
STEP_MIN = 1e-3
STEP_MAX = 1e-1
GA_Q_W = GA_HEADS * HEAD_DIM
GA_KV_W = GA_KV_HEADS * HEAD_DIM
NA_W = NA_HEADS * HEAD_DIM
IN_SPLITS = (GA_Q_W, GA_KV_W, GA_KV_W, SSM_WIDTH, NA_W, NA_W, NA_W, N_BRANCH * D_MODEL)
IN_WIDTH = GA_Q_W + 2 * GA_KV_W + SSM_WIDTH + 3 * NA_W + N_BRANCH * D_MODEL

kernel_name = 'hybrid_flow_trunk_step'


def rmsnorm(x, g):
    xf = x.astype(jnp.float32)
    y = xf * lax.rsqrt(jnp.mean(xf * xf, axis=-1, keepdims=True) + EPS)
    return (y * g.astype(jnp.float32)).astype(x.dtype)


def adaln(cvec, w, b):
    m = jax.nn.silu(cvec) @ w + b
    return m.reshape(cvec.shape[0], 6, D_MODEL)


def axial_rope(x):
    B, L, H, dh = x.shape
    nf = dh // 4
    t = jnp.arange(L)
    pos = jnp.stack([t // GRID_W, t % GRID_W]).astype(jnp.float32)
    inv = ROPE_THETA ** (-jnp.arange(nf, dtype=jnp.float32) / nf)
    ang = (pos[:, :, None] * inv).transpose(1, 0, 2)[:, None]
    cos, sin = jnp.cos(ang), jnp.sin(ang)
    xf = x.astype(jnp.float32).reshape(B, L, H, 2, 2, nf)
    x1, x2 = xf[..., 0, :], xf[..., 1, :]
    out = jnp.stack([x1 * cos - x2 * sin, x1 * sin + x2 * cos], axis=-2)
    return out.reshape(B, L, H, dh).astype(x.dtype)


def block_attention(q, k, v):
    B, Lq, H, dh = q.shape
    G = k.shape[2]
    R = H // G
    nb = Lq // Q_BLOCK
    scale = dh ** -0.5
    qb = q.reshape(B, nb, Q_BLOCK, G, R, dh).swapaxes(0, 1)

    def one_block(q_i):
        s = jnp.einsum('bqgrd,bkgd->bgrqk', q_i, k).astype(jnp.float32) * scale
        p = jax.nn.softmax(s, axis=-1).astype(v.dtype)
        return jnp.einsum('bgrqk,bkgd->bqgrd', p, v)

    out = lax.map(one_block, qb)
    return out.swapaxes(0, 1).reshape(B, Lq, H * dh)


def neighbourhood_attention(q, k, v, kc, vc, rpb):
    B, L, H, dh = q.shape
    rows = L // GRID_W
    kr_n = min(NA_WIN_ROWS, rows)
    kc_n = NA_WIN_COLS
    K = kr_n * kc_n
    t = jnp.arange(L)
    r = t // GRID_W
    col = t % GRID_W
    r0 = jnp.clip(r - kr_n // 2, 0, rows - kr_n)
    c0 = jnp.clip(col - kc_n // 2, 0, GRID_W - kc_n)
    key_r = r0[:, None] + jnp.arange(kr_n)
    key_c = c0[:, None] + jnp.arange(kc_n)
    idx = (key_r[:, :, None] * GRID_W + key_c[:, None, :]).reshape(L, K)
    dr = (key_r - r[:, None] + NA_WIN_ROWS - 1)[:, :, None]
    dc = (key_c - col[:, None] + NA_WIN_COLS - 1)[:, None, :]
    bias = rpb[:, dr, dc].reshape(H, L, K)
    nb = L // Q_BLOCK
    scale = dh ** -0.5
    qb = q.reshape(B, nb, Q_BLOCK, H, dh).swapaxes(0, 1)
    idxb = idx.reshape(nb, Q_BLOCK, K)
    biasb = bias.reshape(H, nb, Q_BLOCK, K).swapaxes(0, 1)

    def one_block(args):
        q_i, idx_i, bias_i = args
        k_i = k[:, idx_i]
        v_i = v[:, idx_i]
        s_loc = jnp.einsum('bqhd,bqkhd->bhqk', q_i, k_i).astype(jnp.float32) * scale + bias_i.astype(jnp.float32)
        s_ctx = jnp.einsum('bqhd,bchd->bhqc', q_i, kc).astype(jnp.float32) * scale
        p = jax.nn.softmax(jnp.concatenate([s_loc, s_ctx], axis=-1), axis=-1).astype(v.dtype)
        return (jnp.einsum('bhqk,bqkhd->bqhd', p[..., :K], v_i)
                + jnp.einsum('bhqc,bchd->bqhd', p[..., K:], vc))

    out = lax.map(one_block, (qb, idxb, biasb))
    return out.swapaxes(0, 1).reshape(B, L, H * dh)


def linear_recurrence(bu, lam_bar, h0, reverse):
    a = jnp.broadcast_to(lam_bar, bu.shape)

    def combine(e1, e2):
        a1, b1 = e1
        a2, b2 = e2
        return a2 * a1, a2 * b1 + b2

    a_cum, b_cum = lax.associative_scan(combine, (a, bu), axis=1, reverse=reverse)
    return b_cum + a_cum * h0[:, None]


def s5_mixer(u, lp, h0):
    B, L, _ = u.shape
    f32 = jnp.float32
    ug = u.astype(f32).reshape(B, L, SSM_GROUPS, SSM_GROUP_CH).astype(jnp.complex64)
    outs = []
    finals = []
    for d in range(2):
        lam = lax.complex(lp['lam_re'][d].astype(f32), lp['lam_im'][d].astype(f32))
        dt = jnp.exp(lp['log_step'][d].astype(f32))[:, None]
        lam_bar = jnp.exp(lam * dt)
        b = lax.complex(lp['b_re'][d].astype(f32), lp['b_im'][d].astype(f32))
        b_bar = ((lam_bar - 1.0) / lam)[..., None] * b
        bu = jnp.einsum('blgh,gph->blgp', ug, b_bar)
        states = linear_recurrence(bu, lam_bar, h0[:, d], reverse=(d == 1))
        cmat = lax.complex(lp['c_re'][d].astype(f32), lp['c_im'][d].astype(f32))
        outs.append(jnp.real(jnp.einsum('blgp,ghp->blgh', states, cmat)))
        finals.append(states[:, L - 1] if d == 0 else states[:, 0])
    y = (outs[0] + outs[1]).reshape(B, L, SSM_WIDTH) + lp['ssm_d'].astype(f32) * u.astype(f32)
    g = jax.nn.gelu(y).astype(u.dtype)
    out = g * jax.nn.sigmoid(g @ lp['w_glu'])
    return out, jnp.stack(finals, axis=1)


def conv_ffn(h, w_up, conv_w, conv_b, w_down):
    u = h @ w_up
    up = jnp.pad(u, ((0, 0), (1, 1), (0, 0)))
    u = up[:, :-2] * conv_w[0] + up[:, 1:-1] * conv_w[1] + up[:, 2:] * conv_w[2] + conv_b
    a, g = jnp.split(u, 2, axis=-1)
    return (jax.nn.silu(g) * a) @ w_down


def trunk_layer(x, mod, lp, cache):
    B, L, _ = x.shape
    sh_m, sc_m, gt_m, sh_f, sc_f, gt_f = [mod[:, i][:, None] for i in range(6)]
    h = rmsnorm(x, lp['norm_g'][0]) * (1 + sc_m) + sh_m
    z = h @ lp['w_in']
    offs = []
    acc = 0
    for s in IN_SPLITS[:-1]:
        acc += s
        offs.append(acc)
    zq, zk, zv, zu, nq, nk, nv, zg = jnp.split(z, offs, axis=-1)
    qa = rmsnorm(zq.reshape(B, L, GA_HEADS, HEAD_DIM), lp['qk_g'][0])
    ka = rmsnorm(zk.reshape(B, L, GA_KV_HEADS, HEAD_DIM), lp['qk_g'][1])
    va = zv.reshape(B, L, GA_KV_HEADS, HEAD_DIM)
    qn = nq.reshape(B, L, NA_HEADS, HEAD_DIM)
    kn = nk.reshape(B, L, NA_HEADS, HEAD_DIM)
    vn = nv.reshape(B, L, NA_HEADS, HEAD_DIM)
    if cache is None:
        ya = block_attention(qa, ka, va)
        yc = block_attention(qn, kn, vn)
        h0 = jnp.zeros((B, 2, SSM_GROUPS, SSM_STATE), jnp.complex64)
        yb, fin = s5_mixer(zu, lp, h0)
        ctx_tensors = (ka, va, kn, vn, jnp.real(fin), jnp.imag(fin))
    else:
        ck_a, cv_a, ck_n, cv_n, s_re, s_im = cache
        qa = axial_rope(qa)
        ka = axial_rope(ka)
        ya = block_attention(qa, jnp.concatenate([ka, ck_a], axis=1), jnp.concatenate([va, cv_a], axis=1))
        yc = neighbourhood_attention(qn, kn, vn, ck_n, cv_n, lp['na_rpb'])
        h0 = lax.complex(s_re.astype(jnp.float32), s_im.astype(jnp.float32))
        yb, _ = s5_mixer(zu, lp, h0)
        ctx_tensors = None
    gates = jax.nn.sigmoid(zg.astype(jnp.float32)).astype(x.dtype).reshape(B, L, N_BRANCH, D_MODEL)
    merged = (gates[:, :, 0] * (ya @ lp['w_br_a']) + gates[:, :, 1] * (yb @ lp['w_br_b'])
              + gates[:, :, 2] * (yc @ lp['w_br_c']))
    x = x + gt_m * rmsnorm(merged @ lp['w_out'], lp['norm_g'][1])
    h = rmsnorm(x, lp['norm_g'][2]) * (1 + sc_f) + sh_f
    f = conv_ffn(h, lp['w_up'], lp['conv_w'], lp['conv_b'], lp['w_down'])
    x = x + gt_f * rmsnorm(f, lp['norm_g'][3])
    return x, ctx_tensors


def setup_inputs(seed: int = 0) -> dict:
    key = jax.random.key(seed)
    ks = jax.random.split(key, 40)
    f32 = jnp.float32
    D = D_MODEL
    G = SSM_GROUPS
    P = SSM_STATE
    Hg = SSM_GROUP_CH

    def nrm(k, shape, s):
        return s * jax.random.normal(k, shape, f32)

    return {
        'x_prompt': nrm(ks[0], (BATCH, SEQ, D), 1.0),
        'x_sample': nrm(ks[1], (DEC_BATCH, DEC_SEQ, D), 1.0),
        'c': nrm(ks[2], (DEC_BATCH, D), 1.0),
        'cache_ga_k': nrm(ks[3], (DEC_BATCH, DEPTH, PAST_LEN, GA_KV_HEADS, HEAD_DIM), 1.0),
        'cache_ga_v': nrm(ks[4], (DEC_BATCH, DEPTH, PAST_LEN, GA_KV_HEADS, HEAD_DIM), 1.0),
        'cache_na_k': nrm(ks[5], (DEC_BATCH, DEPTH, PAST_LEN, NA_HEADS, HEAD_DIM), 1.0),
        'cache_na_v': nrm(ks[6], (DEC_BATCH, DEPTH, PAST_LEN, NA_HEADS, HEAD_DIM), 1.0),
        'state_ssm_re': nrm(ks[7], (DEC_BATCH, DEPTH, 2, G, P), 0.1),
        'state_ssm_im': nrm(ks[8], (DEC_BATCH, DEPTH, 2, G, P), 0.1),
        'c_ctx': nrm(ks[9], (D,), 1.0),
        'w_mod': nrm(ks[10], (DEPTH, D, 6 * D), 0.5 * D ** -0.5),
        'b_mod': nrm(ks[11], (DEPTH, 6 * D), 0.01),
        'norm_g': 1.0 + nrm(ks[12], (DEPTH, 4, D), 0.01),
        'w_in': nrm(ks[13], (DEPTH, D, IN_WIDTH), D ** -0.5),
        'qk_norm_g': 1.0 + nrm(ks[14], (DEPTH, 2, HEAD_DIM), 0.01),
        'na_rpb': nrm(ks[15], (DEPTH, NA_HEADS, 2 * NA_WIN_ROWS - 1, 2 * NA_WIN_COLS - 1), 0.1),
        'ssm_lam_re': -0.5 + nrm(ks[16], (DEPTH, 2, G, P), 0.01),
        'ssm_lam_im': math.pi * jnp.arange(P, dtype=f32) + nrm(ks[17], (DEPTH, 2, G, P), 0.01),
        'ssm_log_step': jax.random.uniform(ks[18], (DEPTH, 2, G), f32, math.log(STEP_MIN), math.log(STEP_MAX)),
        'ssm_b_re': nrm(ks[19], (DEPTH, 2, G, P, Hg), (2 * Hg) ** -0.5),
        'ssm_b_im': nrm(ks[20], (DEPTH, 2, G, P, Hg), (2 * Hg) ** -0.5),
        'ssm_c_re': nrm(ks[21], (DEPTH, 2, G, Hg, P), P ** -0.5),
        'ssm_c_im': nrm(ks[22], (DEPTH, 2, G, Hg, P), P ** -0.5),
        'ssm_d': nrm(ks[23], (DEPTH, SSM_WIDTH), 1.0),
        'w_glu': nrm(ks[24], (DEPTH, SSM_WIDTH, SSM_WIDTH), SSM_WIDTH ** -0.5),
        'w_br_a': nrm(ks[25], (DEPTH, GA_Q_W, D), GA_Q_W ** -0.5),
        'w_br_b': nrm(ks[26], (DEPTH, SSM_WIDTH, D), SSM_WIDTH ** -0.5),
        'w_br_c': nrm(ks[27], (DEPTH, NA_W, D), NA_W ** -0.5),
        'w_out': nrm(ks[28], (DEPTH, D, D), D ** -0.5),
        'w_up': nrm(ks[29], (DEPTH, D, 2 * D_FF), D ** -0.5),
        'conv_w': nrm(ks[30], (DEPTH, 3, 2 * D_FF), 3 ** -0.5),
        'conv_b': nrm(ks[31], (DEPTH, 2 * D_FF), 0.01),
        'w_down': nrm(ks[32], (DEPTH, D_FF, D), D_FF ** -0.5),
    }


def reference(x_prompt, x_sample, c, cache_ga_k, cache_ga_v, cache_na_k, cache_na_v, state_ssm_re, state_ssm_im,
              c_ctx, w_mod, b_mod, norm_g, w_in, qk_norm_g, na_rpb, ssm_lam_re, ssm_lam_im, ssm_log_step,
              ssm_b_re, ssm_b_im, ssm_c_re, ssm_c_im, ssm_d, w_glu, w_br_a, w_br_b, w_br_c, w_out,
              w_up, conv_w, conv_b, w_down):
    y_p = x_prompt
    y_s = x_sample
    ga_k, ga_v, na_k, na_v, s_re, s_im = [], [], [], [], [], []
    for l in range(DEPTH):
        lp = {
            'norm_g': norm_g[l], 'w_in': w_in[l], 'qk_g': qk_norm_g[l], 'na_rpb': na_rpb[l],
            'lam_re': ssm_lam_re[l], 'lam_im': ssm_lam_im[l], 'log_step': ssm_log_step[l],
            'b_re': ssm_b_re[l], 'b_im': ssm_b_im[l], 'c_re': ssm_c_re[l], 'c_im': ssm_c_im[l],
            'ssm_d': ssm_d[l], 'w_glu': w_glu[l], 'w_br_a': w_br_a[l], 'w_br_b': w_br_b[l],
            'w_br_c': w_br_c[l], 'w_out': w_out[l], 'w_up': w_up[l], 'conv_w': conv_w[l],
            'conv_b': conv_b[l], 'w_down': w_down[l],
        }
        mod_ctx = adaln(c_ctx[None], w_mod[l], b_mod[l])
        mod_lat = adaln(c, w_mod[l], b_mod[l])
        y_p, ctx_t = trunk_layer(y_p, mod_ctx, lp, None)
        cache_l = (cache_ga_k[:, l], cache_ga_v[:, l], cache_na_k[:, l], cache_na_v[:, l],
                   state_ssm_re[:, l], state_ssm_im[:, l])
        y_s, _ = trunk_layer(y_s, mod_lat, lp, cache_l)
        ga_k.append(ctx_t[0])
        ga_v.append(ctx_t[1])
        na_k.append(ctx_t[2])
        na_v.append(ctx_t[3])
        s_re.append(ctx_t[4])
        s_im.append(ctx_t[5])
    new_ga_k = jnp.stack(ga_k, axis=1)
    new_ga_v = jnp.stack(ga_v, axis=1)
    new_na_k = jnp.stack(na_k, axis=1)
    new_na_v = jnp.stack(na_v, axis=1)
    new_ssm_re = jnp.stack(s_re, axis=1)
    new_ssm_im = jnp.stack(s_im, axis=1)
    return (y_p, y_s, new_ga_k, new_ga_v, new_na_k, new_na_v, new_ssm_re, new_ssm_im)
```

```cpp
#include <hip/hip_runtime.h>
#include <hip/hip_cooperative_groups.h>
#include <cstdio>
namespace cg = cooperative_groups;

#ifndef DUPMASK
#define DUPMASK 0
#endif
#ifndef SINGLE_LAUNCH
#define SINGLE_LAUNCH 1
#endif

typedef unsigned short u16;
typedef __attribute__((ext_vector_type(8))) short bf16x8;
typedef __attribute__((ext_vector_type(4))) float f32x4;
#define DI __device__ __forceinline__

constexpr int NT = 24576, NTC = 8192;
constexpr int NPHASE = 24;
constexpr int SMEM_BYTES = 135168 + 320 + 16;
constexpr int LDS_STAGE = 49152;

constexpr size_t O_MOD  = 0;
constexpr size_t O_ROPE = 524288;
constexpr size_t O_WT   = 1048576;
constexpr size_t WT_IN  = O_WT;
constexpr size_t WT_BR  = WT_IN + 12058624;
constexpr size_t WT_OUT = WT_BR + 3145728;
constexpr size_t WT_UP  = WT_OUT + 2097152;
constexpr size_t WT_DN  = WT_UP + 11534336;
constexpr size_t WT_GLU = WT_DN + 5767168;
constexpr size_t O_WST  = WT_GLU + 524288;
constexpr size_t O_WOUT = O_WST + 4194304;
constexpr size_t O_LAMT = O_WOUT + 8388608;
constexpr size_t O_USIDE= O_LAMT + 32768;
constexpr size_t O_H    = O_USIDE + 2883584;
constexpr size_t O_MIX  = O_H + 50331648;
constexpr size_t O_QGA  = O_MIX;
constexpr size_t O_UC   = O_MIX + 25165824;
constexpr size_t O_QNA  = O_MIX + 50331648;
constexpr size_t O_KGA  = O_MIX + 75497472;
constexpr size_t O_VTGA = O_KGA + 6815744;
constexpr size_t O_KNA  = O_VTGA + 6815744;
constexpr size_t O_VTNA = O_KNA + 27262976;
constexpr size_t O_SB   = O_MIX + 143654912;
constexpr size_t O_XIN  = O_SB + 25165824;
constexpr size_t O_ACT  = O_MIX;
constexpr size_t O_MG   = O_KGA;
constexpr size_t O_OB   = O_MIX;
constexpr size_t O_F    = O_H;
constexpr size_t O_BAR  = O_XIN + 25165824;
constexpr size_t WT_UP2 = O_BAR + 65536;
constexpr size_t WT_DN2 = WT_UP2 + 11534336;
constexpr size_t OUT_GAK = 25165824, OUT_GAV = 27262976, OUT_NAK = 29360128, OUT_NAV = 37748736, OUT_SRE = 46137344, OUT_SIM = 46399488;

struct P {
  const float *x_prompt, *x_sample, *c, *cgk, *cgv, *cnk, *cnv, *sre, *sim, *c_ctx, *w_mod, *b_mod, *norm_g, *w_in, *qk_g, *rpb,
      *lam_re, *lam_im, *log_step, *b_re, *b_im, *c_re, *c_im, *ssm_d, *w_glu, *w_br_a, *w_br_b, *w_br_c, *w_out, *w_up, *conv_w,
      *conv_b, *w_down;
  float* out;
  char* ws;
};

DI int tidx() { int t = threadIdx.x; asm volatile("" : "+v"(t)); return t; }
DI u16 f2bf(float f) { unsigned u = __float_as_uint(f); u += 0x7fffu + ((u >> 16) & 1u); return (u16)(u >> 16); }
DI float bf2f(unsigned h) { return __uint_as_float(h << 16); }
typedef float f32x2_t __attribute__((ext_vector_type(2)));
typedef __bf16 bf16x2_t __attribute__((ext_vector_type(2)));
DI unsigned pack2(float a, float b) { f32x2_t v = {a, b}; bf16x2_t r = __builtin_convertvector(v, bf16x2_t); return __builtin_bit_cast(unsigned, r); }
DI float bflo(unsigned u) { return __uint_as_float(u << 16); }
DI float bfhi(unsigned u) { return __uint_as_float(u & 0xffff0000u); }
DI void st_bf4(u16* p, float a, float b, float c, float d) { uint2 v; v.x = pack2(a, b); v.y = pack2(c, d); *(uint2*)p = v; }
DI float wave_sum(float v) {
#pragma unroll
  for (int o = 32; o; o >>= 1) v += __shfl_xor(v, o);
  return v;
}
DI float sigmoidf_(float x) { return __builtin_amdgcn_rcpf(1.f + __expf(-x)); }
DI int vblock() { int per = gridDim.x >> 3; return (gridDim.x & 7) ? (int)blockIdx.x : (int)((blockIdx.x & 7) * per + (blockIdx.x >> 3)); }

template <int NTB, class TF, class FF>
DI void gemm_acc(f32x4 (&acc)[4][NTB], TF trow, FF frow, int K, char* smem) {
  const int tid = tidx(), lane = tid & 63, wave = tid >> 6, wm = wave & 3, wn = wave >> 2;
  const int lr = tid >> 3, lc = tid & 7, l15 = lane & 15, q4 = lane >> 4;
  const u16* tp0 = trow(lr) + lc * 8;
  const u16* tp1 = trow(lr + 64) + lc * 8;
  const u16* tp2 = tp0;
  const u16* tp3 = tp0;
  if (NTB == 4) { tp2 = trow(lr + 128) + lc * 8; tp3 = trow(lr + 192) + lc * 8; }
  const u16* fp0 = frow(lr) + lc * 8;
  const u16* fp1 = frow(lr + 64) + lc * 8;
  const int wofs = lr * 128 + ((lc ^ (lr & 7)) << 4);
  uint4 t0 = *(const uint4*)tp0, t1 = *(const uint4*)tp1, t2 = t0, t3 = t0;
  if (NTB == 4) { t2 = *(const uint4*)tp2; t3 = *(const uint4*)tp3; }
  uint4 f0 = *(const uint4*)fp0, f1 = *(const uint4*)fp1;
  __syncthreads();
  *(uint4*)(smem + wofs) = t0; *(uint4*)(smem + wofs + 8192) = t1;
  if (NTB == 4) { *(uint4*)(smem + wofs + 16384) = t2; *(uint4*)(smem + wofs + 24576) = t3; }
  *(uint4*)(smem + 32768 + wofs) = f0; *(uint4*)(smem + 40960 + wofs) = f1;
  __syncthreads();
  const int nk = K >> 6;
  const int tro = (wm * (16 * NTB) + l15) * 128, fro = 32768 + (wn * 64 + l15) * 128, sw = l15 & 7;
#pragma unroll 1
  for (int kt = 0; kt < nk; ++kt) {
    const char* st = smem + (kt & 1) * LDS_STAGE;
    const bool more = (kt + 1 < nk);
    if (more) {
      const int ko = (kt + 1) * 64;
      t0 = *(const uint4*)(tp0 + ko); t1 = *(const uint4*)(tp1 + ko);
      if (NTB == 4) { t2 = *(const uint4*)(tp2 + ko); t3 = *(const uint4*)(tp3 + ko); }
      f0 = *(const uint4*)(fp0 + ko); f1 = *(const uint4*)(fp1 + ko);
    }
    __builtin_amdgcn_sched_barrier(0);
#pragma unroll
    for (int ks = 0; ks < 2; ++ks) {
      bf16x8 ff[4], tt[NTB];
      const int co = ((ks * 4 + q4) ^ sw) << 4;
#pragma unroll
      for (int i = 0; i < 4; ++i) ff[i] = *(const bf16x8*)(st + fro + i * 2048 + co);
#pragma unroll
      for (int i = 0; i < NTB; ++i) tt[i] = *(const bf16x8*)(st + tro + i * 2048 + co);
#pragma unroll
      for (int fb = 0; fb < 4; ++fb)
#pragma unroll
        for (int tb = 0; tb < NTB; ++tb) acc[fb][tb] = __builtin_amdgcn_mfma_f32_16x16x32_bf16(ff[fb], tt[tb], acc[fb][tb], 0, 0, 0);
      __builtin_amdgcn_sched_barrier(0);
    }
    if (more) {
      char* sn = smem + ((kt + 1) & 1) * LDS_STAGE;
      *(uint4*)(sn + wofs) = t0; *(uint4*)(sn + wofs + 8192) = t1;
      if (NTB == 4) { *(uint4*)(sn + wofs + 16384) = t2; *(uint4*)(sn + wofs + 24576) = t3; }
      *(uint4*)(sn + 32768 + wofs) = f0; *(uint4*)(sn + 40960 + wofs) = f1;
    }
    __syncthreads();
  }
}

#define ZERO_ACC(a) _Pragma("unroll") for (int i_ = 0; i_ < 4; ++i_) _Pragma("unroll") for (int j_ = 0; j_ < (int)(sizeof(a[0]) / sizeof(a[0][0])); ++j_) a[i_][j_] = f32x4{0.f, 0.f, 0.f, 0.f};

#define LAS __attribute__((address_space(3)))
constexpr int HTB = 16384;
DI int lds_byte(int r, int c) { const int st = (r >> 4) * 2 + (c >> 5), rr = r & 15, cc = c & 31, ob = rr * 64 + cc * 2; return st * 1024 + (ob ^ (((ob >> 9) & 1) << 5)); }
DI int perm32(int rho) { const int n = rho >> 4, i = rho & 15; return 8 * (i >> 2) + 4 * n + (i & 3); }
DI void stage_rc(int b, int& R, int& C) { const int st = b / 1024, sb = b % 1024, swz = sb ^ (((sb >> 9) & 1) << 5); R = (st >> 1) * 16 + swz / 64; C = (st & 1) * 32 + (swz % 64) / 2; }

DI void gemm256(LAS unsigned char* lds, const char* cA, size_t hstepA, unsigned voffA0, unsigned voffA1, const char* cB, size_t hstepB, unsigned voffB0, unsigned voffB1,
                int nt, f32x4 (&acc)[2][2][4][2], bool half = false) {
  const int tid = tidx(), wid = __builtin_amdgcn_readfirstlane(tid >> 6), lane = tid & 63, wr = wid >> 2, wc = wid & 3, fr = lane & 15, fq = lane >> 4;
  const size_t kstep = 128;
  const unsigned ldsw = (unsigned)wid * 1024u;
  const int aoff = lds_byte(wr * 64 + fr, fq * 8), boff = lds_byte(wc * 32 + fr, fq * 8);
#define G_SA(b, h) (((b) * 2 + (h)) * HTB)
#define G_SB(b, h) ((4 + (b) * 2 + (h)) * HTB)
#define G_STAGE(bufoff, gbase, v0, v1) do { \
    __builtin_amdgcn_global_load_lds((const unsigned*)((const char*)(gbase) + (v0)), (LAS unsigned*)(lds + (bufoff) + ldsw), 16, 0, 0); \
    __builtin_amdgcn_global_load_lds((const unsigned*)((const char*)(gbase) + (v1)), (LAS unsigned*)(lds + (bufoff) + ldsw + 8192), 16, 0, 0); } while (0)
#define G_STA(bufoff, gbase) G_STAGE(bufoff, gbase, voffA0, voffA1)
#define G_STB(bufoff, gbase) G_STAGE(bufoff, gbase, voffB0, voffB1)
#define G_LDA(dst, b, h) do { _Pragma("unroll") for (int m = 0; m < 4; ++m) _Pragma("unroll") for (int k = 0; k < 2; ++k) dst[m][k] = *(const LAS bf16x8*)(lds + G_SA(b, h) + aoff + m * 2048 + k * 1024); } while (0)
#define G_LDB(dst, b, h) do { _Pragma("unroll") for (int n = 0; n < 2; ++n) _Pragma("unroll") for (int k = 0; k < 2; ++k) dst[n][k] = *(const LAS bf16x8*)(lds + G_SB(b, h) + boff + n * 2048 + k * 1024); } while (0)
#define G_MMA(ai, bj, At, Bt) do { __builtin_amdgcn_s_setprio(1); _Pragma("unroll") for (int m = 0; m < 4; ++m) _Pragma("unroll") for (int n = 0; n < 2; ++n) _Pragma("unroll") for (int k = 0; k < 2; ++k) \
    acc[ai][bj][m][n] = __builtin_amdgcn_mfma_f32_16x16x32_bf16(Bt[n][k], At[m][k], acc[ai][bj][m][n], 0, 0, 0); __builtin_amdgcn_s_setprio(0); } while (0)
#define G_WAIT_V(n) asm volatile("s_waitcnt vmcnt(" #n ")" ::: "memory")
#define G_WAIT_L(n) asm volatile("s_waitcnt lgkmcnt(" #n ")" ::: "memory")
#define G_BAR __builtin_amdgcn_s_barrier()
#define G_SCHED __builtin_amdgcn_sched_barrier(0)
  bf16x8 At[4][2], B0[2][2], B1[2][2];
  G_STB(G_SB(0, 0), cB); G_STB(G_SB(0, 1), cB + hstepB); G_STA(G_SA(0, 0), cA); G_STA(G_SA(0, 1), cA + hstepA);
  if (wr == 1) G_BAR;
  G_WAIT_V(2); G_BAR;
  G_STB(G_SB(1, 0), cB + kstep); G_STA(G_SA(1, 0), cA + kstep); G_STB(G_SB(1, 1), cB + hstepB + kstep);
  G_WAIT_V(6); G_BAR;
#pragma unroll 1
  for (int t = 0; t < nt; t += 2) {
    const bool last = (t == nt - 2);
    const char* a1 = cA + (size_t)(t + 1) * kstep;
    const char* a2 = last ? cA : cA + (size_t)(t + 2) * kstep;
    const char* b2 = last ? cB : cB + (size_t)(t + 2) * kstep;
    const char* a3 = a2 + kstep;
    const char* b3 = b2 + kstep;
    G_LDB(B0, 0, 0); G_LDB(B1, 0, 1); G_SCHED; G_LDA(At, 0, 0); G_STA(G_SA(1, 1), a1 + hstepA);
    G_WAIT_V(8); G_WAIT_L(0); G_BAR; G_MMA(0, 0, At, B0); G_MMA(0, 1, At, B1); G_BAR; G_SCHED;
    G_LDA(At, 0, 1); G_STB(G_SB(0, 0), b2); G_STB(G_SB(0, 1), b2 + hstepB); G_STA(G_SA(0, 0), a2);
    G_WAIT_V(8); G_WAIT_L(0); G_BAR; if (!half) { G_MMA(1, 0, At, B0); G_MMA(1, 1, At, B1); } G_BAR; G_SCHED;
    G_LDB(B0, 1, 0); G_LDB(B1, 1, 1); G_SCHED; G_LDA(At, 1, 0); G_STA(G_SA(0, 1), a2 + hstepA);
    G_WAIT_V(8); G_WAIT_L(0); G_BAR; G_MMA(0, 0, At, B0); G_MMA(0, 1, At, B1); G_BAR; G_SCHED;
    G_LDA(At, 1, 1); G_STB(G_SB(1, 0), b3); G_STB(G_SB(1, 1), b3 + hstepB); G_STA(G_SA(1, 0), a3);
    G_WAIT_V(8); G_WAIT_L(0); G_BAR; if (!half) { G_MMA(1, 0, At, B0); G_MMA(1, 1, At, B1); } G_BAR; G_SCHED;
  }
  G_WAIT_V(0);
  if (wr == 0) G_BAR;
  G_BAR;
}
DI void gemm256c(LAS unsigned char* lds, const char* cA, size_t hstepA, const char* cB, size_t hstepB, int K, int nt, const char* nA, size_t nhA, const char* nB, size_t nhB, int nK,
                 bool has_next, bool first, bool lastcall, f32x4 (&acc)[2][2][4][2]) {
  const int tid = tidx(), wid = __builtin_amdgcn_readfirstlane(tid >> 6), lane = tid & 63, wr = wid >> 2, wc = wid & 3, fr = lane & 15, fq = lane >> 4;
  const size_t kstep = 128;
  const unsigned ldsw = (unsigned)wid * 1024u;
  const int aoff = lds_byte(wr * 64 + fr, fq * 8), boff = lds_byte(wc * 32 + fr, fq * 8);
  int R0, C0, R1, C1;
  stage_rc(tid * 16, R0, C0);
  stage_rc(tid * 16 + 8192, R1, C1);
  const unsigned voffA0 = (unsigned)(R0 * K + C0) * 2u, voffA1 = (unsigned)(R1 * K + C1) * 2u;
  const int RB0 = (R0 & ~31) + perm32(R0 & 31), RB1 = (R1 & ~31) + perm32(R1 & 31);
  const unsigned voffB0 = (unsigned)(RB0 * K + C0) * 2u, voffB1 = (unsigned)(RB1 * K + C1) * 2u;
  bf16x8 At[4][2], B0[2][2], B1[2][2];
  if (first) {
    G_STB(G_SB(0, 0), cB); G_STB(G_SB(0, 1), cB + hstepB); G_STA(G_SA(0, 0), cA); G_STA(G_SA(0, 1), cA + hstepA);
    if (wr == 1) G_BAR;
    G_WAIT_V(2); G_BAR;
    G_STB(G_SB(1, 0), cB + kstep); G_STA(G_SA(1, 0), cA + kstep); G_STB(G_SB(1, 1), cB + hstepB + kstep);
    G_WAIT_V(6); G_BAR;
  }
#pragma unroll 1
  for (int t = 0; t < nt; t += 2) {
    const bool tonext = (t == nt - 2) && has_next;
    const bool wrap = (t == nt - 2) && !has_next;
    const char* a1 = cA + (size_t)(t + 1) * kstep;
    const char* a2 = tonext ? nA : (wrap ? cA : cA + (size_t)(t + 2) * kstep);
    const char* b2 = tonext ? nB : (wrap ? cB : cB + (size_t)(t + 2) * kstep);
    const size_t hA2 = tonext ? nhA : hstepA, hB2 = tonext ? nhB : hstepB;
    const int K2 = tonext ? nK : K;
    const unsigned x0 = (unsigned)(R0 * K2 + C0) * 2u, x1 = (unsigned)(R1 * K2 + C1) * 2u, y0 = (unsigned)(RB0 * K2 + C0) * 2u, y1 = (unsigned)(RB1 * K2 + C1) * 2u;
    G_LDB(B0, 0, 0); G_LDB(B1, 0, 1); G_SCHED; G_LDA(At, 0, 0); G_STA(G_SA(1, 1), a1 + hstepA);
    G_WAIT_V(8); G_WAIT_L(0); G_BAR; G_MMA(0, 0, At, B0); G_MMA(0, 1, At, B1); G_BAR; G_SCHED;
    G_LDA(At, 0, 1); G_STAGE(G_SB(0, 0), b2, y0, y1); G_STAGE(G_SB(0, 1), b2 + hB2, y0, y1); G_STAGE(G_SA(0, 0), a2, x0, x1);
    G_WAIT_V(8); G_WAIT_L(0); G_BAR; G_MMA(1, 0, At, B0); G_MMA(1, 1, At, B1); G_BAR; G_SCHED;
    G_LDB(B0, 1, 0); G_LDB(B1, 1, 1); G_SCHED; G_LDA(At, 1, 0); G_STAGE(G_SA(0, 1), a2 + hA2, x0, x1);
    G_WAIT_V(8); G_WAIT_L(0); G_BAR; G_MMA(0, 0, At, B0); G_MMA(0, 1, At, B1); G_BAR; G_SCHED;
    G_LDA(At, 1, 1); G_STAGE(G_SB(1, 0), b2 + kstep, y0, y1); G_STAGE(G_SB(1, 1), b2 + kstep + hB2, y0, y1); G_STAGE(G_SA(1, 0), a2 + kstep, x0, x1);
    G_WAIT_V(8); G_WAIT_L(0); G_BAR; G_MMA(1, 0, At, B0); G_MMA(1, 1, At, B1); G_BAR; G_SCHED;
  }
  if (lastcall) {
    G_WAIT_V(0);
    if (wr == 0) G_BAR;
    G_BAR;
  }
}
#define ZERO_ACC8(a) _Pragma("unroll") for (int a_ = 0; a_ < 2; ++a_) _Pragma("unroll") for (int b_ = 0; b_ < 2; ++b_) _Pragma("unroll") for (int m_ = 0; m_ < 4; ++m_) \
    _Pragma("unroll") for (int n_ = 0; n_ < 2; ++n_) a[a_][b_][m_][n_] = f32x4{0.f, 0.f, 0.f, 0.f};
DI void voff_nat(int K, unsigned& v0, unsigned& v1) { const int tid = tidx(); int R, C; stage_rc(tid * 16, R, C); v0 = (unsigned)(R * K + C) * 2u; stage_rc(tid * 16 + 8192, R, C); v1 = (unsigned)(R * K + C) * 2u; }
DI void voff_perm(int K, unsigned& v0, unsigned& v1) { const int tid = tidx(); int R, C; stage_rc(tid * 16, R, C); v0 = (unsigned)(((R & ~31) + perm32(R & 31)) * K + C) * 2u;
  stage_rc(tid * 16 + 8192, R, C); v1 = (unsigned)(((R & ~31) + perm32(R & 31)) * K + C) * 2u; }
DI void st_bf8(u16* p, const f32x4& a, const f32x4& b) { uint4 v; v.x = pack2(a[0], a[1]); v.y = pack2(a[2], a[3]); v.z = pack2(b[0], b[1]); v.w = pack2(b[2], b[3]); *(uint4*)p = v; }
DI void voff_grp(int K, unsigned& v0, unsigned& v1) { const int tid = tidx(); int R, C; stage_rc(tid * 16, R, C); v0 = (unsigned)((64 * (R >> 5) + (R & 31)) * K + C) * 2u;
  stage_rc(tid * 16 + 8192, R, C); v1 = (unsigned)((64 * (R >> 5) + (R & 31)) * K + C) * 2u; }

DI void mod_item(const P& p, int it, char* smem) {
  float* sc = (float*)smem;
  float* red = sc + 9 * 1024;
  const int tid = tidx(), lane = tid & 63, wave = tid >> 6;
  const int l = it / 96, jb = (it % 96) * 64;
  const float* pc_ctx = p.c_ctx;
  const float* pc_lat = p.c;
  __syncthreads();
  for (int e = tid; e < 9 * 1024; e += 512) {
    int mi = e >> 10, k = e & 1023;
    const float* cp = mi == 0 ? pc_ctx + k : pc_lat + (mi - 1) * 1024 + k;
    float v = *cp;
    sc[e] = v * __builtin_amdgcn_rcpf(1.f + __expf(-v));
  }
  __syncthreads();
  float a[9];
#pragma unroll
  for (int i = 0; i < 9; ++i) a[i] = 0.f;
  const float* w = p.w_mod + (size_t)l * 1024 * 6144 + jb + lane;
  for (int k = wave * 128; k < wave * 128 + 128; ++k) {
    float wv = w[(size_t)k * 6144];
#pragma unroll
    for (int i = 0; i < 9; ++i) a[i] += wv * sc[i * 1024 + k];
  }
#pragma unroll
  for (int i = 0; i < 9; ++i) red[(wave * 9 + i) * 64 + lane] = a[i];
  __syncthreads();
  float* mod = (float*)(p.ws + O_MOD);
  for (int e = tid; e < 576; e += 512) {
    int mi = e >> 6, ln = e & 63;
    float s = 0.f;
#pragma unroll
    for (int wv = 0; wv < 8; ++wv) s += red[(wv * 9 + mi) * 64 + ln];
    mod[(size_t)(l * 9 + mi) * 6144 + jb + ln] = s + p.b_mod[l * 6144 + jb + ln];
  }
}

DI void conv_tile(const float* src, int ld, int K, u16* dst, int kt, int nt, char* smem) {
  float* tl = (float*)smem;
  const int tid = tidx();
  __syncthreads();
  float v[32];
#pragma unroll
  for (int i = 0; i < 32; ++i) { const int e = tid + i * 512; v[i] = src[(size_t)(kt * 64 + (e >> 8)) * ld + nt * 256 + (e & 255)]; }
#pragma unroll
  for (int i = 0; i < 32; ++i) { const int e = tid + i * 512; tl[(e >> 8) * 257 + (e & 255)] = v[i]; }
  __syncthreads();
#pragma unroll
  for (int j = 0; j < 4; ++j) {
    const int c = tid + j * 512, n = c >> 3, kc = (c & 7) * 8;
    uint4 o;
    o.x = pack2(tl[(kc + 0) * 257 + n], tl[(kc + 1) * 257 + n]);
    o.y = pack2(tl[(kc + 2) * 257 + n], tl[(kc + 3) * 257 + n]);
    o.z = pack2(tl[(kc + 4) * 257 + n], tl[(kc + 5) * 257 + n]);
    o.w = pack2(tl[(kc + 6) * 257 + n], tl[(kc + 7) * 257 + n]);
    *(uint4*)(dst + (size_t)(nt * 256 + n) * K + kt * 64 + kc) = o;
  }
}
constexpr int NCONV_A = 544, NCONV = 1072;
DI void conv_item(const P& p, int l, int it, char* smem) {
  char* ws = p.ws;
  const float *s_in = p.w_in, *s_a = p.w_br_a, *s_b = p.w_br_b, *s_c = p.w_br_c, *s_out = p.w_out, *s_up = p.w_up, *s_dn = p.w_down, *s_glu = p.w_glu;
  const float* src; int ld, K, kt, nt; u16* dst;
  if (it < 368) { src = s_in + (size_t)l * 1024 * 5888; ld = 5888; K = 1024; dst = (u16*)(ws + WT_IN); kt = it & 15; nt = it >> 4; }
  else if (it < 464) {
    it -= 368;
    int br = it >> 5, r = it & 31;
    src = (br == 0 ? s_a : br == 1 ? s_b : s_c) + (size_t)l * 512 * 1024; ld = 1024; K = 512; dst = (u16*)(ws + WT_BR) + (size_t)br * 1024 * 512; kt = r & 7; nt = r >> 3;
  } else if (it < 528) { it -= 464; src = s_out + (size_t)l * 1024 * 1024; ld = 1024; K = 1024; dst = (u16*)(ws + WT_OUT); kt = it & 15; nt = it >> 4; }
  else if (it < 544) { it -= 528; src = s_glu + (size_t)l * 512 * 512; ld = 512; K = 512; dst = (u16*)(ws + WT_GLU); kt = it & 7; nt = it >> 3; }
  else if (it < 896) { it -= 544; src = s_up + (size_t)l * 1024 * 5632; ld = 5632; K = 1024; dst = (u16*)(ws + (l ? WT_UP2 : WT_UP)); kt = it & 15; nt = it >> 4; }
  else { it -= 896; src = s_dn + (size_t)l * 2816 * 1024; ld = 1024; K = 2816; dst = (u16*)(ws + (l ? WT_DN2 : WT_DN)); kt = it % 44; nt = it / 44; }
  conv_tile(src, ld, K, dst, kt, nt, smem);
}

DI float2 cmul(float2 a, float2 b) { return make_float2(a.x * b.x - a.y * b.y, a.x * b.y + a.y * b.x); }
DI void ssm_tables(const P& p, int l, int g, char* smem) {
  float2* pw = (float2*)smem;
  float2* bb = pw + 2 * 17 * 64;
  float2* cc = bb + 2048;
  float* kl = (float*)(cc + 2048);
  const int tid = tidx();
  __syncthreads();
  for (int e = tid; e < 2 * 17 * 64; e += 512) {
    int d = e / (17 * 64), r = e % (17 * 64), ee = r >> 6, pp = r & 63;
    int li = ((l * 2 + d) * 32 + g) * 64 + pp;
    float lr_ = p.lam_re[li], lim = p.lam_im[li], dt = expf(p.log_step[(l * 2 + d) * 32 + g]);
    float mag = expf((float)ee * (lr_ * dt)), s, c;
    sincosf((float)ee * (lim * dt), &s, &c);
    pw[e] = make_float2(mag * c, mag * s);
  }
  for (int e = tid; e < 2048; e += 512) {
    int d = e >> 10, h = (e >> 6) & 15, pp = e & 63;
    int ci = (((l * 2 + d) * 32 + g) * 16 + h) * 64 + pp;
    cc[e] = make_float2(p.c_re[ci], p.c_im[ci]);
  }
  __syncthreads();
  for (int e = tid; e < 2048; e += 512) {
    int d = e >> 10, pp = (e >> 4) & 63, h = e & 15;
    int li = ((l * 2 + d) * 32 + g) * 64 + pp;
    float lr_ = p.lam_re[li], lim = p.lam_im[li];
    float2 lb = pw[(d * 17 + 1) * 64 + pp];
    float nr = lb.x - 1.f, ni = lb.y, den = lr_ * lr_ + lim * lim;
    float2 q = make_float2((nr * lr_ + ni * lim) / den, (ni * lr_ - nr * lim) / den);
    float2 b = make_float2(p.b_re[(size_t)li * 16 + h], p.b_im[(size_t)li * 16 + h]);
    bb[e] = cmul(q, b);
  }
  __syncthreads();
  for (int e = tid; e < 31 * 256; e += 512) {
    int lg = e >> 8, h = (e >> 4) & 15, h2 = e & 15, lag = lg - 15;
    float s = 0.f;
    if (lag >= 0)
      for (int pp = 0; pp < 64; ++pp) {
        float2 cw = cmul(cc[(0 * 16 + h) * 64 + pp], pw[(0 * 17 + lag) * 64 + pp]);
        float2 b = bb[(0 * 64 + pp) * 16 + h2];
        s += cw.x * b.x - cw.y * b.y;
      }
    if (lag <= 0)
      for (int pp = 0; pp < 64; ++pp) {
        float2 cw = cmul(cc[(1 * 16 + h) * 64 + pp], pw[(1 * 17 - lag) * 64 + pp]);
        float2 b = bb[(1 * 64 + pp) * 16 + h2];
        s += cw.x * b.x - cw.y * b.y;
      }
    kl[e] = s;
  }
  __syncthreads();
  u16* wout = (u16*)(p.ws + O_WOUT) + (size_t)g * 256 * 512;
  for (int c = tid; c < 16384; c += 512) {
    int n = c >> 6, kc = (c & 63) * 8, t = n >> 4, h = n & 15;
    float v[8];
#pragma unroll
    for (int i = 0; i < 8; ++i) {
      int k = kc + i;
      if (kc < 256) {
        int s = k >> 4, h2 = k & 15;
        v[i] = kl[(t - s + 15) * 256 + h * 16 + h2];
      } else {
        int d = (kc >= 384) ? 1 : 0, kk = k - 256 - d * 128, pp = kk >> 1, ri = kk & 1, e = d ? 16 - t : t + 1;
        float2 cl = cmul(cc[(d * 16 + h) * 64 + pp], pw[(d * 17 + e) * 64 + pp]);
        v[i] = ri ? -cl.y : cl.x;
      }
    }
    uint4 o; o.x = pack2(v[0], v[1]); o.y = pack2(v[2], v[3]); o.z = pack2(v[4], v[5]); o.w = pack2(v[6], v[7]);
    *(uint4*)(wout + (size_t)n * 512 + kc) = o;
  }
  u16* wst = (u16*)(p.ws + O_WST) + (size_t)g * 256 * 256;
  for (int c = tid; c < 8192; c += 512) {
    int n = c >> 5, kc = (c & 31) * 8, d = n >> 7, pp = (n >> 1) & 63, ri = n & 1;
    float v[8];
#pragma unroll
    for (int i = 0; i < 8; ++i) {
      int k = kc + i, s = k >> 4, h2 = k & 15, e = d ? s : 15 - s;
      float2 z = cmul(pw[(d * 17 + e) * 64 + pp], bb[(d * 64 + pp) * 16 + h2]);
      v[i] = ri ? z.y : z.x;
    }
    uint4 o; o.x = pack2(v[0], v[1]); o.y = pack2(v[2], v[3]); o.z = pack2(v[4], v[5]); o.w = pack2(v[6], v[7]);
    *(uint4*)(wst + (size_t)n * 256 + kc) = o;
  }
  if (tid < 128) {
    int d = tid >> 6, pp = tid & 63;
    ((float2*)(p.ws + O_LAMT))[(d * 32 + g) * 64 + pp] = pw[(d * 17 + 16) * 64 + pp];
  }
}

DI void cache_convert(const P& p, int l) {
  const int gsz = gridDim.x * 512, gid = blockIdx.x * 512 + tidx();
  u16* kga = (u16*)(p.ws + O_KGA) + 1048576; u16* vtga = (u16*)(p.ws + O_VTGA) + 1048576;
  u16* kna = (u16*)(p.ws + O_KNA) + 4194304; u16* vtna = (u16*)(p.ws + O_VTNA) + 4194304;
  const float *cgk = p.cgk, *cgv = p.cgv, *cnk = p.cnk, *cnv = p.cnv;
  for (int idx = gid; idx < 32768 + 131072; idx += gsz) {
    const bool ga = idx < 32768;
    const int id = ga ? idx : idx - 32768, NH = ga ? 2 : 8;
    const int t = id & 255, dc = (id >> 8) & 7, bh = id >> 11, head = bh % NH, b = bh / NH;
    const size_t so = ((((size_t)b * 2 + l) * 256 + t) * NH + head) * 64 + dc * 8;
    const float* ks = (ga ? cgk : cnk) + so;
    const float* vs = (ga ? cgv : cnv) + so;
    float4 k0 = *(const float4*)ks, k1 = *(const float4*)(ks + 4), v0 = *(const float4*)vs, v1 = *(const float4*)(vs + 4);
    u16* kd = (ga ? kga : kna) + ((size_t)bh * 2304 + 2048 + t) * 64 + dc * 8;
    uint4 o; o.x = pack2(k0.x, k0.y); o.y = pack2(k0.z, k0.w); o.z = pack2(k1.x, k1.y); o.w = pack2(k1.z, k1.w);
    *(uint4*)kd = o;
    u16* vd = (ga ? vtga : vtna) + ((size_t)bh * 64 + dc * 8) * 2304 + 2048 + t;
    vd[0] = f2bf(v0.x); vd[2304] = f2bf(v0.y); vd[2 * 2304] = f2bf(v0.z); vd[3 * 2304] = f2bf(v0.w);
    vd[4 * 2304] = f2bf(v1.x); vd[5 * 2304] = f2bf(v1.y); vd[6 * 2304] = f2bf(v1.z); vd[7 * 2304] = f2bf(v1.w);
  }
}

DI void prep_layer0(const P& p, char* smem) {
  const int G = gridDim.x, b = blockIdx.x;
  if (G >= 64) {
    if (b < 32) ssm_tables(p, 0, b, smem);
    else
      for (int it = b - 32; it < 192 + NCONV; it += G - 32) {
        if (it < 192) mod_item(p, it, smem);
        else conv_item(p, 0, it - 192, smem);
      }
  } else {
    for (int it = b; it < 32 + 192 + NCONV; it += G) {
      if (it < 32) ssm_tables(p, 0, it, smem);
      else if (it < 224) mod_item(p, it - 32, smem);
      else conv_item(p, 0, it - 224, smem);
    }
  }
  cache_convert(p, 0);
}

DI void rope_table(const P& p) {
  float2* rt = (float2*)(p.ws + O_ROPE);
  for (int e = blockIdx.x * 512 + tidx(); e < 2048 * 32; e += gridDim.x * 512) {
    int t = e >> 5, a = (e >> 4) & 1, f = e & 15;
    float pos = (float)(a ? (t & 63) : (t >> 6));
    float inv = powf(10000.f, -(float)f / 16.f);
    float s, c;
    sincosf(pos * inv, &s, &c);
    rt[e] = make_float2(c, s);
  }
}

DI void row_phase(const P& p, int flags, int lr, int gi_r, int gt_idx, const u16* R, int lh, int gi_h, int sh_idx, int sc_idx, bool nostore = false) {
  const int lane = tidx() & 63, wave = tidx() >> 6;
  const float* mod = (const float*)(p.ws + O_MOD);
  u16* H = (u16*)(p.ws + O_H);
  const float *xp = p.x_prompt, *xsm = p.x_sample;
  float* xo = p.out;
  const float* ng = p.norm_g;
  const int nw = gridDim.x * 8, rpw = (NT + nw - 1) / nw, w = blockIdx.x * 8 + wave;
  const int rbeg = w * rpw, rend = min(NT, rbeg + rpw);
  float4 gR[4], gtv[4], gH[4], scv[4], shv[4];
  int cur_mi = -1;
  float4 xn[4];
  uint2 rn[4];
#define ROW_LOAD(row_) do { \
    const float* xs_ = (flags & 1) ? ((row_) < NTC ? xp + (size_t)(row_) * 1024 : xsm + (size_t)((row_) - NTC) * 1024) : xo + (size_t)(row_) * 1024; \
    _Pragma("unroll") for (int i = 0; i < 4; ++i) xn[i] = *(const float4*)(xs_ + i * 256 + lane * 4); \
    if (flags & 2) { _Pragma("unroll") for (int i = 0; i < 4; ++i) rn[i] = *(const uint2*)(R + (size_t)(row_) * 1024 + i * 256 + lane * 4); } } while (0)
  if (rbeg < rend) ROW_LOAD(rbeg);
  for (int row = rbeg; row < rend; ++row) {
    const int mi = row < NTC ? 0 : 1 + ((row - NTC) >> 11);
    if (mi != cur_mi) {
      cur_mi = mi;
      if (flags & 2) {
        const float* g = ng + (lr * 4 + gi_r) * 1024;
        const float* gt = mod + ((size_t)(lr * 9 + mi) * 6 + gt_idx) * 1024;
#pragma unroll
        for (int i = 0; i < 4; ++i) { gR[i] = *(const float4*)(g + i * 256 + lane * 4); gtv[i] = *(const float4*)(gt + i * 256 + lane * 4); }
      }
      if (flags & 4) {
        const float* g = ng + (lh * 4 + gi_h) * 1024;
        const float* sh = mod + ((size_t)(lh * 9 + mi) * 6 + sh_idx) * 1024;
        const float* sc = mod + ((size_t)(lh * 9 + mi) * 6 + sc_idx) * 1024;
#pragma unroll
        for (int i = 0; i < 4; ++i) { gH[i] = *(const float4*)(g + i * 256 + lane * 4); scv[i] = *(const float4*)(sc + i * 256 + lane * 4); shv[i] = *(const float4*)(sh + i * 256 + lane * 4); }
      }
    }
    float4 x[4];
    uint2 rcur[4];
#pragma unroll
    for (int i = 0; i < 4; ++i) { x[i] = xn[i]; rcur[i] = rn[i]; }
    if (row + 1 < rend) ROW_LOAD(row + 1);
    if (flags & 2) {
      float r[4][4];
      float ssq = 0.f;
#pragma unroll
      for (int i = 0; i < 4; ++i) {
        const uint2 rv = rcur[i];
        r[i][0] = bflo(rv.x); r[i][1] = bfhi(rv.x); r[i][2] = bflo(rv.y); r[i][3] = bfhi(rv.y);
        ssq += r[i][0] * r[i][0] + r[i][1] * r[i][1] + r[i][2] * r[i][2] + r[i][3] * r[i][3];
      }
      ssq = wave_sum(ssq);
      const float rstd = rsqrtf(ssq * (1.f / 1024.f) + 1e-6f);
#pragma unroll
      for (int i = 0; i < 4; ++i) {
        x[i].x += gtv[i].x * (r[i][0] * rstd * gR[i].x); x[i].y += gtv[i].y * (r[i][1] * rstd * gR[i].y);
        x[i].z += gtv[i].z * (r[i][2] * rstd * gR[i].z); x[i].w += gtv[i].w * (r[i][3] * rstd * gR[i].w);
        if (!nostore || rstd == -1.f) *(float4*)(xo + (size_t)row * 1024 + i * 256 + lane * 4) = x[i];
      }
    }
    if (flags & 4) {
      float ssq = 0.f;
#pragma unroll
      for (int i = 0; i < 4; ++i) ssq += x[i].x * x[i].x + x[i].y * x[i].y + x[i].z * x[i].z + x[i].w * x[i].w;
      ssq = wave_sum(ssq);
      const float rstd = rsqrtf(ssq * (1.f / 1024.f) + 1e-6f);
#pragma unroll
      for (int i = 0; i < 4; ++i) {
        if (!nostore || rstd == -1.f)
          st_bf4(H + (size_t)row * 1024 + i * 256 + lane * 4, x[i].x * rstd * gH[i].x * (1.f + scv[i].x) + shv[i].x, x[i].y * rstd * gH[i].y * (1.f + scv[i].y) + shv[i].y,
                 x[i].z * rstd * gH[i].z * (1.f + scv[i].z) + shv[i].z, x[i].w * rstd * gH[i].w * (1.f + scv[i].w) + shv[i].w);
      }
    }
  }
#undef ROW_LOAD
}

DI void inproj_tile(const P& p, int l, int it, char* smem) {
  const int pm = it / 11, pn = it % 11, m0 = pm * 256;
  const int tid = tidx(), lane = tid & 63, wave = tid >> 6, wr = wave >> 2, wc = wave & 3, l15 = lane & 15, q4 = lane >> 4;
  f32x4 acc8[2][2][4][2];
  ZERO_ACC8(acc8);
  {
    unsigned va0, va1, vb0, vb1;
    voff_nat(1024, va0, va1);
    voff_grp(1024, vb0, vb1);
    gemm256((LAS unsigned char*)smem, (const char*)(p.ws + O_H) + (size_t)m0 * 2048, (size_t)128 * 2048, va0, va1, (const char*)(p.ws + WT_IN) + (size_t)pn * 256 * 2048, (size_t)32 * 2048,
            vb0, vb1, 16, acc8);
  }
  const int nb = pn * 256 + wc * 64;
  const bool lat = m0 >= NTC;
  char* ws = p.ws;
#pragma unroll
  for (int tb = 0; tb < 8; ++tb) {
    const int tk = m0 + (tb >> 2) * 128 + wr * 64 + (tb & 3) * 16 + l15;
    int b, t;
    if (!lat) { b = tk >> 8; t = tk & 255; } else { b = (tk - NTC) >> 11; t = (tk - NTC) & 2047; }
    float v[4][4];
#pragma unroll
    for (int fb = 0; fb < 4; ++fb)
#pragma unroll
      for (int j = 0; j < 4; ++j) v[fb][j] = acc8[tb >> 2][fb >> 1][tb & 3][fb & 1][j];
    if (nb < 640) {
      float ssq = 0.f;
#pragma unroll
      for (int fb = 0; fb < 4; ++fb)
#pragma unroll
        for (int j = 0; j < 4; ++j) ssq += v[fb][j] * v[fb][j];
      ssq += __shfl_xor(ssq, 16);
      ssq += __shfl_xor(ssq, 32);
      const float rstd = rsqrtf(ssq * (1.f / 64.f) + 1e-6f);
      const float* g = p.qk_g + (l * 2 + (nb >= 512 ? 1 : 0)) * 64;
#pragma unroll
      for (int fb = 0; fb < 4; ++fb) {
        float4 gv = *(const float4*)(g + fb * 16 + q4 * 4);
        v[fb][0] *= rstd * gv.x; v[fb][1] *= rstd * gv.y; v[fb][2] *= rstd * gv.z; v[fb][3] *= rstd * gv.w;
      }
      if (nb >= 512 && !lat) {
        float* o = p.out + OUT_GAK + (((size_t)(b * 2 + l) * 256 + t) * 2 + ((nb - 512) >> 6)) * 64 + q4 * 4;
#pragma unroll
        for (int fb = 0; fb < 4; ++fb) *(float4*)(o + fb * 16) = make_float4(v[fb][0], v[fb][1], v[fb][2], v[fb][3]);
      }
      if (lat) {
        const float2* rt = (const float2*)(ws + O_ROPE) + t * 32 + q4 * 4;
#pragma unroll
        for (int a = 0; a < 2; ++a)
          {
            const float4 c01 = *(const float4*)(rt + a * 16), c23 = *(const float4*)(rt + a * 16 + 2);
            const float cc[4] = {c01.x, c01.z, c23.x, c23.z}, sn[4] = {c01.y, c01.w, c23.y, c23.w};
#pragma unroll
            for (int j = 0; j < 4; ++j) {
              const float x1 = v[2 * a][j], x2 = v[2 * a + 1][j];
              v[2 * a][j] = x1 * cc[j] - x2 * sn[j];
              v[2 * a + 1][j] = x1 * sn[j] + x2 * cc[j];
            }
          }
      }
      if (nb < 512) {
        u16* o = (u16*)(ws + O_QGA) + (size_t)tk * 512 + nb + q4 * 4;
#pragma unroll
        for (int fb = 0; fb < 4; ++fb) st_bf4(o + fb * 16, v[fb][0], v[fb][1], v[fb][2], v[fb][3]);
      } else {
        const int kvh = (nb - 512) >> 6;
        u16* o = lat ? (u16*)(ws + O_KGA) + 1048576 + ((size_t)(b * 2 + kvh) * 2304 + t) * 64 : (u16*)(ws + O_KGA) + ((size_t)(b * 2 + kvh) * 256 + t) * 64;
#pragma unroll
        for (int fb = 0; fb < 4; ++fb) st_bf4(o + fb * 16 + q4 * 4, v[fb][0], v[fb][1], v[fb][2], v[fb][3]);
      }
    } else if (nb < 768) {
      const int kvh = (nb - 640) >> 6;
      if (!lat) {
        float* o = p.out + OUT_GAV + (((size_t)(b * 2 + l) * 256 + t) * 2 + kvh) * 64 + q4 * 4;
#pragma unroll
        for (int fb = 0; fb < 4; ++fb) *(float4*)(o + fb * 16) = make_float4(v[fb][0], v[fb][1], v[fb][2], v[fb][3]);
      }
      const int st = lat ? 2304 : 256;
      u16* o = lat ? (u16*)(ws + O_VTGA) + 1048576 + ((size_t)(b * 2 + kvh) * 64) * 2304 + t : (u16*)(ws + O_VTGA) + ((size_t)(b * 2 + kvh) * 64) * 256 + t;
#pragma unroll
      for (int fb = 0; fb < 4; ++fb)
#pragma unroll
        for (int j = 0; j < 4; ++j) o[(size_t)(fb * 16 + q4 * 4 + j) * st] = f2bf(v[fb][j]);
    } else if (nb < 1280) {
      const int g0 = (nb - 768) >> 4;
      u16* o = (u16*)(ws + O_UC) + ((size_t)(tk >> 4)) * 256 + (tk & 15) * 16 + q4 * 4;
#pragma unroll
      for (int fb = 0; fb < 4; ++fb) st_bf4(o + (size_t)(g0 + fb) * 1536 * 256, v[fb][0], v[fb][1], v[fb][2], v[fb][3]);
    } else if (nb < 1792) {
      u16* o = (u16*)(ws + O_QNA) + (size_t)tk * 512 + (nb - 1280) + q4 * 4;
#pragma unroll
      for (int fb = 0; fb < 4; ++fb) st_bf4(o + fb * 16, v[fb][0], v[fb][1], v[fb][2], v[fb][3]);
    } else if (nb < 2304) {
      const int h = (nb - 1792) >> 6;
      if (!lat) {
        float* o = p.out + OUT_NAK + (((size_t)(b * 2 + l) * 256 + t) * 8 + h) * 64 + q4 * 4;
#pragma unroll
        for (int fb = 0; fb < 4; ++fb) *(float4*)(o + fb * 16) = make_float4(v[fb][0], v[fb][1], v[fb][2], v[fb][3]);
      }
      u16* o = lat ? (u16*)(ws + O_KNA) + 4194304 + ((size_t)(b * 8 + h) * 2304 + t) * 64 : (u16*)(ws + O_KNA) + ((size_t)(b * 8 + h) * 256 + t) * 64;
#pragma unroll
      for (int fb = 0; fb < 4; ++fb) st_bf4(o + fb * 16 + q4 * 4, v[fb][0], v[fb][1], v[fb][2], v[fb][3]);
    } else {
      const int h = (nb - 2304) >> 6;
      if (!lat) {
        float* o = p.out + OUT_NAV + (((size_t)(b * 2 + l) * 256 + t) * 8 + h) * 64 + q4 * 4;
#pragma unroll
        for (int fb = 0; fb < 4; ++fb) *(float4*)(o + fb * 16) = make_float4(v[fb][0], v[fb][1], v[fb][2], v[fb][3]);
      }
      const int st = lat ? 2304 : 256;
      u16* o = lat ? (u16*)(ws + O_VTNA) + 4194304 + ((size_t)(b * 8 + h) * 64) * 2304 + t : (u16*)(ws + O_VTNA) + ((size_t)(b * 8 + h) * 64) * 256 + t;
#pragma unroll
      for (int fb = 0; fb < 4; ++fb)
#pragma unroll
        for (int j = 0; j < 4; ++j) o[(size_t)(fb * 16 + q4 * 4 + j) * st] = f2bf(v[fb][j]);
    }
  }
}

template <int NQ, int MODE>
DI void attn_block(const u16* Kb, const u16* VTb, int vt_stride, int n1, int base1, int base2, int ntiles,
                           const u16* qp, u16* op, int qstride_blk, char* smem,
                           int na_r, int na_col, int na_rlo, const float* rpbs) {
  const int tid = tidx(), lane = tid & 63, l15 = lane & 15, q4 = lane >> 4, sw = l15 & 7;
  bf16x8 qf[NQ][2];
#pragma unroll
  for (int qb = 0; qb < NQ; ++qb)
#pragma unroll
    for (int ks = 0; ks < 2; ++ks) qf[qb][ks] = *(const bf16x8*)(qp + (size_t)qb * qstride_blk + ks * 32 + q4 * 8);
  f32x4 o[4][NQ];
  float m[NQ];
  f32x4 osum[NQ];
  const uint4 ones_u = {0x3F803F80u, 0x3F803F80u, 0x3F803F80u, 0x3F803F80u};
  const bf16x8 ones = __builtin_bit_cast(bf16x8, ones_u);
#pragma unroll
  for (int qb = 0; qb < NQ; ++qb) {
    m[qb] = -1e30f; osum[qb] = f32x4{0.f, 0.f, 0.f, 0.f};
#pragma unroll
    for (int db = 0; db < 4; ++db) o[db][qb] = f32x4{0.f, 0.f, 0.f, 0.f};
  }
  const int ldr = tid >> 3, ldc = tid & 7;
  const int wofs = ldr * 128 + ((ldc ^ (ldr & 7)) << 4);
  const int vofs = 8192 + ldr * 144 + ldc * 16;
  uint4 kr0, vr0, kr1, vr1;
  {
    const int k0 = (0 < n1) ? base1 : base2;
    kr0 = *(const uint4*)(Kb + (size_t)(k0 + ldr) * 64 + ldc * 8);
    vr0 = *(const uint4*)(VTb + (size_t)ldr * vt_stride + k0 + ldc * 8);
    kr1 = kr0; vr1 = vr0;
    if (1 < ntiles) {
      const int k1 = (1 < n1) ? base1 + 64 : base2 + (1 - n1) * 64;
      kr1 = *(const uint4*)(Kb + (size_t)(k1 + ldr) * 64 + ldc * 8);
      vr1 = *(const uint4*)(VTb + (size_t)ldr * vt_stride + k1 + ldc * 8);
    }
  }
  __syncthreads();
  *(uint4*)(smem + wofs) = kr0; *(uint4*)(smem + vofs) = vr0; *(uint4*)(smem + 17408 + wofs) = kr1; *(uint4*)(smem + 17408 + vofs) = vr1;
  __syncthreads();
  int r0 = 0, c0 = 0;
  if (MODE == 1) { r0 = min(max(na_r - 4, 0), 24); c0 = min(max(na_col - 8, 0), 48); }
  const int npairs = (ntiles + 1) >> 1;
#pragma unroll 1
  for (int ip = 0; ip < npairs; ++ip) {
    const char* stp = smem + (ip & 1) * 34816;
    const bool more = ip + 1 < npairs;
    if (more) {
      const int i0 = 2 * ip + 2;
      const int k0 = (i0 < n1) ? base1 + i0 * 64 : base2 + (i0 - n1) * 64;
      kr0 = *(const uint4*)(Kb + (size_t)(k0 + ldr) * 64 + ldc * 8);
      vr0 = *(const uint4*)(VTb + (size_t)ldr * vt_stride + k0 + ldc * 8);
      if (i0 + 1 < ntiles) {
        const int k1 = (i0 + 1 < n1) ? base1 + (i0 + 1) * 64 : base2 + (i0 + 1 - n1) * 64;
        kr1 = *(const uint4*)(Kb + (size_t)(k1 + ldr) * 64 + ldc * 8);
        vr1 = *(const uint4*)(VTb + (size_t)ldr * vt_stride + k1 + ldc * 8);
      }
    }
#pragma unroll
    for (int sub = 0; sub < 2; ++sub) {
      const int i = 2 * ip + sub;
      if (i < ntiles) {
        const char* st = stp + sub * 17408;
        bool act = true;
        int krow = 0;
        if (MODE == 1 && i < n1) { krow = na_rlo + i; act = (krow >= r0) && (krow < min(max(na_r + NQ - 1 - 4, 0), 24) + 8); }
        if (act) {
          f32x4 s[4][NQ];
    #pragma unroll
          for (int kb = 0; kb < 4; ++kb)
    #pragma unroll
            for (int qb = 0; qb < NQ; ++qb) s[kb][qb] = f32x4{0.f, 0.f, 0.f, 0.f};
          bf16x8 kf[4][2], vf[4][2];
    #pragma unroll
          for (int ks = 0; ks < 2; ++ks)
    #pragma unroll
            for (int kb = 0; kb < 4; ++kb) kf[kb][ks] = *(const bf16x8*)(st + (kb * 16 + l15) * 128 + (((ks * 4 + q4) ^ sw) << 4));
    #pragma unroll
          for (int k2 = 0; k2 < 2; ++k2)
    #pragma unroll
            for (int db = 0; db < 4; ++db) {
              const char* vrow = st + 8192 + (db * 16 + l15) * 144 + k2 * 64 + q4 * 8;
              const uint2 va = *(const uint2*)(vrow), vb = *(const uint2*)(vrow + 32);
              uint4 vv; vv.x = va.x; vv.y = va.y; vv.z = vb.x; vv.w = vb.y;
              vf[db][k2] = __builtin_bit_cast(bf16x8, vv);
            }
          __builtin_amdgcn_sched_barrier(0);
    #pragma unroll
          for (int ks = 0; ks < 2; ++ks)
    #pragma unroll
            for (int kb = 0; kb < 4; ++kb)
    #pragma unroll
              for (int qb = 0; qb < NQ; ++qb) s[kb][qb] = __builtin_amdgcn_mfma_f32_16x16x32_bf16(kf[kb][ks], qf[qb][ks], s[kb][qb], 0, 0, 0);
          __builtin_amdgcn_sched_barrier(0);
          bf16x8 pf[NQ][2];
          const float SC = 0.18033688011112042f;
    #pragma unroll
          for (int qb = 0; qb < NQ; ++qb) {
            float mx = m[qb];
            const bool biased = (MODE == 1 && i < n1);
            if (biased) {
    #pragma unroll
              for (int kb = 0; kb < 4; ++kb)
    #pragma unroll
                for (int j = 0; j < 4; ++j) {
                  const int kc = kb * 16 + q4 * 4 + j;
                  const int nr = na_r + qb, r0q = min(max(nr - 4, 0), 24);
                  const bool ok = (kc >= c0) && (kc < c0 + 16) && (krow >= r0q) && (krow < r0q + 8);
                  const float bias = rpbs[min(max(krow - nr + 7, 0), 14) * 31 + min(max(kc - na_col + 15, 0), 30)];
                  const float v = ok ? s[kb][qb][j] * SC + bias : -INFINITY;
                  s[kb][qb][j] = v;
                  mx = fmaxf(mx, v);
                }
            } else {
              float rm = s[0][qb][0];
    #pragma unroll
              for (int kb = 0; kb < 4; ++kb)
    #pragma unroll
                for (int j = 0; j < 4; ++j) rm = fmaxf(rm, s[kb][qb][j]);
              mx = fmaxf(mx, rm * SC);
            }
            if (__builtin_amdgcn_ballot_w64(mx > m[qb]) != 0ull) {
              mx = fmaxf(mx, __shfl_xor(mx, 16));
              mx = fmaxf(mx, __shfl_xor(mx, 32));
              const float alpha = __builtin_amdgcn_exp2f(m[qb] - mx);
              m[qb] = mx;
    #pragma unroll
              for (int db = 0; db < 4; ++db) o[db][qb] *= alpha;
              osum[qb] *= alpha;
            }
            mx = m[qb];
            if (biased) {
    #pragma unroll
              for (int kb = 0; kb < 4; ++kb)
    #pragma unroll
                for (int j = 0; j < 4; ++j) s[kb][qb][j] = __builtin_amdgcn_exp2f(s[kb][qb][j] - mx);
            } else {
    #pragma unroll
              for (int kb = 0; kb < 4; ++kb)
    #pragma unroll
                for (int j = 0; j < 4; ++j) s[kb][qb][j] = __builtin_amdgcn_exp2f(__builtin_fmaf(s[kb][qb][j], SC, -mx));
            }
    #pragma unroll
            for (int k2 = 0; k2 < 2; ++k2) {
              uint4 pk;
              pk.x = pack2(s[2 * k2][qb][0], s[2 * k2][qb][1]); pk.y = pack2(s[2 * k2][qb][2], s[2 * k2][qb][3]);
              pk.z = pack2(s[2 * k2 + 1][qb][0], s[2 * k2 + 1][qb][1]); pk.w = pack2(s[2 * k2 + 1][qb][2], s[2 * k2 + 1][qb][3]);
              pf[qb][k2] = __builtin_bit_cast(bf16x8, pk);
              osum[qb] = __builtin_amdgcn_mfma_f32_16x16x32_bf16(ones, pf[qb][k2], osum[qb], 0, 0, 0);
            }
          }
          __builtin_amdgcn_sched_barrier(0);
    #pragma unroll
          for (int k2 = 0; k2 < 2; ++k2)
    #pragma unroll
            for (int db = 0; db < 4; ++db)
    #pragma unroll
              for (int qb = 0; qb < NQ; ++qb) o[db][qb] = __builtin_amdgcn_mfma_f32_16x16x32_bf16(vf[db][k2], pf[qb][k2], o[db][qb], 0, 0, 0);
        }
      }
    }
    if (more) {
      char* sn = smem + ((ip + 1) & 1) * 34816;
      *(uint4*)(sn + wofs) = kr0; *(uint4*)(sn + vofs) = vr0; *(uint4*)(sn + 17408 + wofs) = kr1; *(uint4*)(sn + 17408 + vofs) = vr1;
    }
    __syncthreads();
  }
#pragma unroll
  for (int qb = 0; qb < NQ; ++qb) {
    const float inv = __builtin_amdgcn_rcpf(osum[qb][0]);
#pragma unroll
    for (int db = 0; db < 4; ++db)
      st_bf4(op + (size_t)qb * qstride_blk + db * 16 + q4 * 4, o[db][qb][0] * inv, o[db][qb][1] * inv, o[db][qb][2] * inv, o[db][qb][3] * inv);
  }
}

DI void dense_item(const P& p, int it, char* smem, bool dummy) {
  const int it0 = it;
  const int wave = tidx() >> 6, l15 = tidx() & 15;
  char* ws = p.ws;
  const u16 *Kb, *VTb;
  u16* q;
  int stride, ntiles;
  if (it < 512) {
    const int qt = it & 31, bk = it >> 5, kvh = bk & 1, b = bk >> 1;
    const int tok = NTC + b * 2048 + qt * 64 + (wave >> 2) * 32 + l15, head = kvh * 4 + (wave & 3);
    q = (u16*)(ws + O_QGA) + (size_t)tok * 512 + head * 64;
    Kb = (const u16*)(ws + O_KGA) + 1048576 + (size_t)bk * 2304 * 64; VTb = (const u16*)(ws + O_VTGA) + 1048576 + (size_t)bk * 64 * 2304;
    stride = 2304; ntiles = 36;
  } else if (it < 768) {
    it -= 512;
    const int qt = it & 3, bk = it >> 2, kvh = bk & 1, b = bk >> 1;
    const int tok = b * 256 + qt * 64 + (wave >> 2) * 32 + l15, head = kvh * 4 + (wave & 3);
    q = (u16*)(ws + O_QGA) + (size_t)tok * 512 + head * 64;
    Kb = (const u16*)(ws + O_KGA) + (size_t)bk * 256 * 64; VTb = (const u16*)(ws + O_VTGA) + (size_t)bk * 64 * 256;
    stride = 256; ntiles = 4;
  } else {
    it -= 768;
    const int tok = (it >> 3) * 256 + wave * 32 + l15, h = it & 7;
    q = (u16*)(ws + O_QNA) + (size_t)tok * 512 + h * 64;
    Kb = (const u16*)(ws + O_KNA) + (size_t)it * 256 * 64; VTb = (const u16*)(ws + O_VTNA) + (size_t)it * 64 * 256;
    stride = 256; ntiles = 4;
  }
  u16* qo = q;
  if (DUPMASK && dummy) qo = (u16*)(ws + O_XIN) + (q - (u16*)(ws + (it0 >= 768 ? O_QNA : O_QGA)));
  attn_block<2, 0>(Kb, VTb, stride, ntiles, 0, 0, ntiles, q, qo, 16 * 512, smem, 0, 0, 0, nullptr);
}
DI void na_item(const P& p, int l, int it, char* smem, bool dummy) {
  const int wave = tidx() >> 6, l15 = tidx() & 15;
  char* ws = p.ws;
  const int rq = it & 7, bh = it >> 3, h = bh & 7, b = bh >> 3;
  float* rpbs = (float*)(smem + 69632);
  __syncthreads();
  for (int e = tidx(); e < 465; e += 512) rpbs[e] = p.rpb[(size_t)(l * 8 + h) * 465 + e] * 1.4426950408889634f;
  const int r = rq * 4 + (wave >> 2) * 2, cq = (wave & 3) * 16;
  const int rlo = min(max(rq * 4 - 4, 0), 24), rhi = min(max(rq * 4 + 3 - 4, 0), 24) + 8, nband = rhi - rlo;
  const int tok = NTC + b * 2048 + r * 64 + cq + l15;
  u16* q = (u16*)(ws + O_QNA) + (size_t)tok * 512 + h * 64;
  attn_block<2, 1>((const u16*)(ws + O_KNA) + 4194304 + (size_t)bh * 2304 * 64, (const u16*)(ws + O_VTNA) + 4194304 + (size_t)bh * 64 * 2304, 2304, nband,
                   rlo * 64, 2048, nband + 4, q, (DUPMASK && dummy) ? (u16*)(ws + O_KGA) + (size_t)(tok & 8191) * 512 + h * 64 : q, 64 * 512, smem, r, cq + l15, rlo, rpbs);
}

DI void s1_tile(const P& p, int it, char* smem) {
  const int g = it / 6, m0 = (it % 6) * 256;
  const int tid = tidx(), lane = tid & 63, wave = tid >> 6, wr = wave >> 2, wc = wave & 3, fr = lane & 15, fq = lane >> 4;
  f32x4 acc8[2][2][4][2];
  ZERO_ACC8(acc8);
  {
    unsigned v0, v1, w0, w1;
    voff_nat(256, v0, v1);
    voff_perm(256, w0, w1);
    gemm256((LAS unsigned char*)smem, (const char*)(p.ws + O_UC) + ((size_t)g * 1536 + m0) * 512, (size_t)128 * 512, v0, v1, (const char*)(p.ws + O_WST) + (size_t)g * 256 * 512, (size_t)128 * 512, w0, w1,
            4, acc8);
  }
  u16* S = (u16*)(p.ws + O_SB) + (size_t)g * 1536 * 256;
  int rb = (m0 + wr * 64 + fr) * 256 + wc * 32 + fq * 8;
  asm volatile("" : "+v"(rb));
#pragma unroll
  for (int ai = 0; ai < 2; ++ai)
#pragma unroll
    for (int m = 0; m < 4; ++m)
#pragma unroll
      for (int bj = 0; bj < 2; ++bj) st_bf8(S + (size_t)(rb + (ai * 128 + m * 16) * 256 + bj * 128), acc8[ai][bj][m][0], acc8[ai][bj][m][1]);
}

DI void scan_item(const P& p, int l, int it) {
  int sq, gq;
  if (it < 64) { sq = 32 + (it >> 3); gq = it & 7; } else { sq = (it - 64) >> 3; gq = (it - 64) & 7; }
  const int tid = tidx(), g = gq * 4 + (tid >> 7), d = (tid >> 6) & 1, pp = tid & 63;
  const int nc = sq < 32 ? 16 : 128, row0 = sq < 32 ? sq * 16 : 512 + (sq - 32) * 128;
  const float2 lt = ((const float2*)(p.ws + O_LAMT))[(d * 32 + g) * 64 + pp];
  float xr = 0.f, xi = 0.f;
  if (sq >= 32) {
    const int si = ((((sq - 32) * 2 + l) * 2 + d) * 32 + g) * 64 + pp;
    xr = p.sre[si]; xi = p.sim[si];
  }
  const unsigned* S = (const unsigned*)(p.ws + O_SB) + ((size_t)g * 1536 + row0) * 128 + d * 64 + pp;
  unsigned* X = (unsigned*)(p.ws + O_XIN) + ((size_t)g * 1536 + row0) * 128 + d * 64 + pp;
  const int c0 = d ? nc - 1 : 0, step = d ? -1 : 1;
  X[(size_t)c0 * 128] = pack2(xr, xi);
  for (int cb = 0; cb < nc; cb += 16) {
    unsigned sv[16];
#pragma unroll
    for (int i = 0; i < 16; ++i) sv[i] = S[(size_t)(c0 + (cb + i) * step) * 128];
#pragma unroll
    for (int i = 0; i < 16; ++i) {
      const int c = c0 + (cb + i) * step;
      const float nr = lt.x * xr - lt.y * xi + bflo(sv[i]), ni = lt.x * xi + lt.y * xr + bfhi(sv[i]);
      xr = nr; xi = ni;
      const int cn = c + step;
      if (cn >= 0 && cn < nc) X[(size_t)cn * 128] = pack2(xr, xi);
    }
  }
  if (sq < 32) {
    const size_t oi = ((((size_t)sq * 2 + l) * 2 + d) * 32 + g) * 64 + pp;
    p.out[OUT_SRE + oi] = xr; p.out[OUT_SIM + oi] = xi;
  }
}

DI void s3_tile(const P& p, int l, int it, char* smem) {
  const int g = it / 6, m0 = (it % 6) * 256;
  const int tid = tidx(), lane = tid & 63, wave = tid >> 6, wr = wave >> 2, wc = wave & 3, fr = lane & 15, fq = lane >> 4;
  const u16* A1 = (const u16*)(p.ws + O_UC) + (size_t)g * 1536 * 256;
  f32x4 acc8[2][2][4][2];
  ZERO_ACC8(acc8);
  {
    unsigned va0, va1, vb0, vb1;
    voff_nat(256, va0, va1);
    voff_perm(512, vb0, vb1);
    const char* B = (const char*)(p.ws + O_WOUT) + (size_t)g * 256 * 1024;
    gemm256((LAS unsigned char*)smem, (const char*)A1 + (size_t)m0 * 512, (size_t)128 * 512, va0, va1, B, (size_t)128 * 1024, vb0, vb1, 4, acc8);
    gemm256((LAS unsigned char*)smem, (const char*)(p.ws + O_XIN) + ((size_t)g * 1536 + m0) * 512, (size_t)128 * 512, va0, va1, B + 512, (size_t)128 * 1024, vb0, vb1, 4, acc8);
  }
  u16* G = (u16*)(p.ws + O_SB);
  const float4 d0 = *(const float4*)(p.ssm_d + l * 512 + g * 16 + (fq & 1) * 8), d1 = *(const float4*)(p.ssm_d + l * 512 + g * 16 + (fq & 1) * 8 + 4);
  int rbase = m0 + wr * 64 + fr;
  asm volatile("" : "+v"(rbase));
#pragma unroll
  for (int ai = 0; ai < 2; ++ai)
#pragma unroll
    for (int m = 0; m < 4; ++m) {
#pragma unroll
      for (int bj = 0; bj < 2; ++bj) {
        const int row = rbase + ai * 128 + m * 16, nn = bj * 128 + wc * 32 + fq * 8, t = nn >> 4;
        const uint4 uv = *(const uint4*)(A1 + (size_t)row * 256 + nn);
        f32x4 y0 = acc8[ai][bj][m][0], y1 = acc8[ai][bj][m][1];
        y0[0] += d0.x * bflo(uv.x); y0[1] += d0.y * bfhi(uv.x); y0[2] += d0.z * bflo(uv.y); y0[3] += d0.w * bfhi(uv.y);
        y1[0] += d1.x * bflo(uv.z); y1[1] += d1.y * bfhi(uv.z); y1[2] += d1.z * bflo(uv.w); y1[3] += d1.w * bfhi(uv.w);
#pragma unroll
        for (int j = 0; j < 4; ++j) {
          const float x = y0[j], z = y1[j];
          y0[j] = 0.5f * x * (1.f + tanhf(0.7978845608028654f * (x + 0.044715f * x * x * x)));
          y1[j] = 0.5f * z * (1.f + tanhf(0.7978845608028654f * (z + 0.044715f * z * z * z)));
        }
        st_bf8(G + (size_t)(row * 16 + t) * 512 + g * 16 + (fq & 1) * 8, y0, y1);
      }
      if (m == 3) asm volatile("" ::: "memory");
    }
}

DI void glu_tile(const P& p, int it, char* smem) {
  const int m0 = (it >> 1) * 256, pn = it & 1;
  const int tid = tidx(), lane = tid & 63, wave = tid >> 6, wr = wave >> 2, wc = wave & 3, fr = lane & 15, fq = lane >> 4;
  const u16* A = (const u16*)(p.ws + O_SB);
  f32x4 acc8[2][2][4][2];
  ZERO_ACC8(acc8);
  {
    unsigned v0, v1, w0, w1;
    voff_nat(512, v0, v1);
    voff_perm(512, w0, w1);
    gemm256((LAS unsigned char*)smem, (const char*)A + (size_t)m0 * 1024, (size_t)128 * 1024, v0, v1, (const char*)(p.ws + WT_GLU) + (size_t)pn * 256 * 1024, (size_t)128 * 1024, w0, w1, 8, acc8);
  }
  u16* Y = (u16*)(p.ws + O_UC);
  int rb = (m0 + wr * 64 + fr) * 512 + pn * 256 + wc * 32 + fq * 8;
  asm volatile("" : "+v"(rb));
#pragma unroll
  for (int ai = 0; ai < 2; ++ai)
#pragma unroll
    for (int m = 0; m < 4; ++m) {
#pragma unroll
      for (int bj = 0; bj < 2; ++bj) {
        const size_t o = (size_t)(rb + (ai * 128 + m * 16) * 512 + bj * 128);
        const uint4 gv = *(const uint4*)(A + o);
        f32x4 y0, y1;
        y0[0] = bflo(gv.x) * sigmoidf_(acc8[ai][bj][m][0][0]); y0[1] = bfhi(gv.x) * sigmoidf_(acc8[ai][bj][m][0][1]);
        y0[2] = bflo(gv.y) * sigmoidf_(acc8[ai][bj][m][0][2]); y0[3] = bfhi(gv.y) * sigmoidf_(acc8[ai][bj][m][0][3]);
        y1[0] = bflo(gv.z) * sigmoidf_(acc8[ai][bj][m][1][0]); y1[1] = bfhi(gv.z) * sigmoidf_(acc8[ai][bj][m][1][1]);
        y1[2] = bflo(gv.w) * sigmoidf_(acc8[ai][bj][m][1][2]); y1[3] = bfhi(gv.w) * sigmoidf_(acc8[ai][bj][m][1][3]);
        st_bf8(Y + o, y0, y1);
      }
      if (m == 3) asm volatile("" ::: "memory");
    }
}

DI void merge_tile(const P& p, int it, char* smem) {
  const int pm = it >> 2, pn = it & 3, m0 = pm * 256;
  const int tid = tidx(), lane = tid & 63, wave = tid >> 6, wr = wave >> 2, wc = wave & 3, fr = lane & 15, fq = lane >> 4;
  unsigned char* T = (unsigned char*)(p.ws + O_SB) + (size_t)blockIdx.x * 196608;
  f32x4 acc8[2][2][4][2];
#pragma unroll 1
  for (int br = 0; br < 3; ++br) {
    ZERO_ACC8(acc8);
    {
      const char* Hb = (const char*)(p.ws + O_H) + (size_t)m0 * 2048;
      const char* Wg = (const char*)(p.ws + WT_IN) + (size_t)(2816 + br * 1024 + pn * 256) * 2048;
      const bool tob = (br == 2);
      gemm256c((LAS unsigned char*)smem, Hb, (size_t)128 * 2048, Wg, (size_t)128 * 2048, 1024, 16, tob ? (const char*)(p.ws + O_QGA) + (size_t)m0 * 1024 : Hb, tob ? (size_t)128 * 1024 : (size_t)128 * 2048,
               tob ? (const char*)(p.ws + WT_BR) + (size_t)(pn * 256) * 1024 : Wg + (size_t)1024 * 2048, tob ? (size_t)128 * 1024 : (size_t)128 * 2048, tob ? 512 : 1024, true, br == 0, false, acc8);
    }
    int tb = (br * 8 + wave) * 8192 + lane * 4;
    asm volatile("" : "+v"(tb));
#pragma unroll
    for (int ai = 0; ai < 2; ++ai)
#pragma unroll
      for (int m = 0; m < 4; ++m)
#pragma unroll
        for (int bj = 0; bj < 2; ++bj)
#pragma unroll
          for (int n = 0; n < 2; ++n) {
            unsigned q = 0;
#pragma unroll
            for (int j = 0; j < 4; ++j) {
              const float g = fmaxf(255.f * __builtin_amdgcn_rcpf(1.f + __builtin_amdgcn_exp2f(acc8[ai][bj][m][n][j] * -1.4426950408889634f)) + 0.5f, 1.f);
              q = __builtin_amdgcn_cvt_pk_u8_f32(g, j, q);
            }
            *(unsigned*)(T + tb + (((ai * 4 + m) * 2 + bj) * 2 + n) * 256) = q;
          }
  }
  ZERO_ACC8(acc8);
#pragma unroll 1
  for (int br = 0; br < 3; ++br) {
    {
      const int nb = br < 2 ? br + 1 : 2;
      const char* Y = p.ws + (br == 0 ? O_QGA : br == 1 ? O_UC : O_QNA);
      const char* Yn = p.ws + (nb == 1 ? O_UC : O_QNA);
      gemm256c((LAS unsigned char*)smem, Y + (size_t)m0 * 1024, (size_t)128 * 1024, (const char*)(p.ws + WT_BR) + ((size_t)br * 1024 + pn * 256) * 1024, (size_t)128 * 1024, 512, 8,
               Yn + (size_t)m0 * 1024, (size_t)128 * 1024, (const char*)(p.ws + WT_BR) + ((size_t)nb * 1024 + pn * 256) * 1024, (size_t)128 * 1024, 512, br < 2, false, br == 2, acc8);
    }
    int tb = (br * 8 + wave) * 8192 + lane * 4;
    asm volatile("" : "+v"(tb));
#pragma unroll
    for (int ai = 0; ai < 2; ++ai)
#pragma unroll
      for (int m = 0; m < 4; ++m)
#pragma unroll
        for (int bj = 0; bj < 2; ++bj)
#pragma unroll
          for (int n = 0; n < 2; ++n) {
            const int off = tb + (((ai * 4 + m) * 2 + bj) * 2 + n) * 256;
            const unsigned qa = *(const unsigned*)(T + off);
            const unsigned qb = (br < 2) ? *(const unsigned*)(T + off + 65536) : 0xffffffffu;
#pragma unroll
            for (int j = 0; j < 4; ++j) {
              const float ga = (float)((qa >> (8 * j)) & 255u), gb = (float)((qb >> (8 * j)) & 255u);
              acc8[ai][bj][m][n][j] *= ga * __builtin_amdgcn_rcpf(gb);
            }
            if (n == 1 && bj == 1 && m == 3) asm volatile("" ::: "memory");
          }
  }
  u16* M = (u16*)(p.ws + O_MG);
  int rb = (m0 + wr * 64 + fr) * 1024 + pn * 256 + wc * 32 + fq * 8;
  asm volatile("" : "+v"(rb));
#pragma unroll
  for (int ai = 0; ai < 2; ++ai)
#pragma unroll
    for (int m = 0; m < 4; ++m)
#pragma unroll
      for (int bj = 0; bj < 2; ++bj) st_bf8(M + (size_t)(rb + (ai * 128 + m * 16) * 1024 + bj * 128), acc8[ai][bj][m][0], acc8[ai][bj][m][1]);
}

template <int K>
DI void plain_tile(const u16* A, const u16* W, u16* O, int m0, int pn, char* smem) {
  const int tid = tidx(), lane = tid & 63, wave = tid >> 6, wr = wave >> 2, wc = wave & 3, fr = lane & 15, fq = lane >> 4;
  f32x4 acc8[2][2][4][2];
  ZERO_ACC8(acc8);
  {
    unsigned v0, v1, w0, w1;
    voff_nat(K, v0, v1);
    voff_perm(K, w0, w1);
    gemm256((LAS unsigned char*)smem, (const char*)A + (size_t)m0 * K * 2, (size_t)128 * K * 2, v0, v1, (const char*)W + (size_t)pn * 256 * K * 2, (size_t)128 * K * 2, w0, w1, K / 64, acc8);
  }
  int rb = (m0 + wr * 64 + fr) * 1024 + pn * 256 + wc * 32 + fq * 8;
  asm volatile("" : "+v"(rb));
#pragma unroll
  for (int ai = 0; ai < 2; ++ai)
#pragma unroll
    for (int m = 0; m < 4; ++m)
#pragma unroll
      for (int bj = 0; bj < 2; ++bj) st_bf8(O + (size_t)(rb + (ai * 128 + m * 16) * 1024 + bj * 128), acc8[ai][bj][m][0], acc8[ai][bj][m][1]);
}
template <int K>
DI void plain_phase(const u16* A, const u16* W, u16* O, int vb, int G, char* smem) {
  for (int it = vb; it < 384; it += G) plain_tile<K>(A, W, O, (it >> 2) * 256, it & 3, smem);
}

DI void up_tile(const P& p, int l, int it, char* smem) {
  const int mt = it / 22, pn = it % 22, m0 = mt * 256, j0 = pn * 128;
  const int tid = tidx(), lane = tid & 63, wave = tid >> 6, wr = wave >> 2, wc = wave & 3, fr = lane & 15, fq = lane >> 4;
  f32x4 acc8[2][2][4][2];
  ZERO_ACC8(acc8);
  {
    unsigned v0, v1, w0, w1;
    voff_nat(1024, v0, v1);
    voff_perm(1024, w0, w1);
    gemm256((LAS unsigned char*)smem, (const char*)(p.ws + O_H) + (size_t)m0 * 2048, (size_t)128 * 2048, v0, v1, (const char*)(p.ws + (l ? WT_UP2 : WT_UP)) + (size_t)j0 * 2048, (size_t)2816 * 2048, w0, w1,
            16, acc8);
  }
  u16* E = (u16*)smem;
#pragma unroll
  for (int ai = 0; ai < 2; ++ai)
#pragma unroll
    for (int m = 0; m < 4; ++m)
#pragma unroll
      for (int bj = 0; bj < 2; ++bj) st_bf8(E + (ai * 128 + wr * 64 + m * 16 + fr) * 264 + bj * 128 + wc * 32 + fq * 8, acc8[ai][bj][m][0], acc8[ai][bj][m][1]);
  __syncthreads();
  {
    const int cg = tid & 15, tg = tid >> 4, ja = j0 + cg * 8;
    const bool lat = mt >= 32;
    const int ti = lat ? ((mt - 32) & 7) : 0;
    const float* cw = p.conv_w + (size_t)l * 3 * 5632;
    const float* cb = p.conv_b + (size_t)l * 5632;
    float wa[3][8], wg[3][8], ba[8], bg[8];
#pragma unroll
    for (int dt = 0; dt < 3; ++dt) {
      const float4 a0 = *(const float4*)(cw + dt * 5632 + ja), a1 = *(const float4*)(cw + dt * 5632 + ja + 4);
      const float4 g0 = *(const float4*)(cw + dt * 5632 + 2816 + ja), g1 = *(const float4*)(cw + dt * 5632 + 2816 + ja + 4);
      wa[dt][0] = a0.x; wa[dt][1] = a0.y; wa[dt][2] = a0.z; wa[dt][3] = a0.w; wa[dt][4] = a1.x; wa[dt][5] = a1.y; wa[dt][6] = a1.z; wa[dt][7] = a1.w;
      wg[dt][0] = g0.x; wg[dt][1] = g0.y; wg[dt][2] = g0.z; wg[dt][3] = g0.w; wg[dt][4] = g1.x; wg[dt][5] = g1.y; wg[dt][6] = g1.z; wg[dt][7] = g1.w;
    }
    {
      const float4 a0 = *(const float4*)(cb + ja), a1 = *(const float4*)(cb + ja + 4), g0 = *(const float4*)(cb + 2816 + ja), g1 = *(const float4*)(cb + 2816 + ja + 4);
      ba[0] = a0.x; ba[1] = a0.y; ba[2] = a0.z; ba[3] = a0.w; ba[4] = a1.x; ba[5] = a1.y; ba[6] = a1.z; ba[7] = a1.w;
      bg[0] = g0.x; bg[1] = g0.y; bg[2] = g0.z; bg[3] = g0.w; bg[4] = g1.x; bg[5] = g1.y; bg[6] = g1.z; bg[7] = g1.w;
    }
    float ra[3][8], rg[3][8];
    auto ldrow = [&](int tt, float (&xa)[8], float (&xg)[8]) {
      if (tt >= 0 && tt < 256) {
        const uint4 ua = *(const uint4*)(E + tt * 264 + cg * 8);
        const uint4 ug = *(const uint4*)(E + tt * 264 + 128 + cg * 8);
        xa[0] = bflo(ua.x); xa[1] = bfhi(ua.x); xa[2] = bflo(ua.y); xa[3] = bfhi(ua.y); xa[4] = bflo(ua.z); xa[5] = bfhi(ua.z); xa[6] = bflo(ua.w); xa[7] = bfhi(ua.w);
        xg[0] = bflo(ug.x); xg[1] = bfhi(ug.x); xg[2] = bflo(ug.y); xg[3] = bfhi(ug.y); xg[4] = bflo(ug.z); xg[5] = bfhi(ug.z); xg[6] = bflo(ug.w); xg[7] = bfhi(ug.w);
      } else {
#pragma unroll
        for (int i = 0; i < 8; ++i) { xa[i] = 0.f; xg[i] = 0.f; }
      }
    };
    const int t0 = tg * 8;
    ldrow(t0 - 1, ra[0], rg[0]);
    ldrow(t0, ra[1], rg[1]);
    u16* o = (u16*)(p.ws + O_ACT) + (size_t)(m0 + t0) * 2816 + ja;
#pragma unroll
    for (int i = 0; i < 8; ++i) {
      const int t = t0 + i;
      ldrow(t + 1, ra[(i + 2) % 3], rg[(i + 2) % 3]);
      const bool defer = lat && ((t == 0 && ti > 0) || (t == 255 && ti < 7));
      if (!defer) {
        float r[8];
#pragma unroll
        for (int c = 0; c < 8; ++c) {
          const float av = ba[c] + wa[0][c] * ra[i % 3][c] + wa[1][c] * ra[(i + 1) % 3][c] + wa[2][c] * ra[(i + 2) % 3][c];
          const float gv = bg[c] + wg[0][c] * rg[i % 3][c] + wg[1][c] * rg[(i + 1) % 3][c] + wg[2][c] * rg[(i + 2) % 3][c];
          r[c] = gv * __builtin_amdgcn_rcpf(1.f + __expf(-gv)) * av;
        }
        uint4 ov; ov.x = pack2(r[0], r[1]); ov.y = pack2(r[2], r[3]); ov.z = pack2(r[4], r[5]); ov.w = pack2(r[6], r[7]);
        *(uint4*)(o + (size_t)i * 2816) = ov;
      }
    }
    if (lat && (tg == 0 || tg == 31)) {
      u16* sd = (u16*)(p.ws + O_USIDE) + ((size_t)(mt - 32) * 4 + (tg ? 2 : 0)) * 5632;
      const int tr = tg ? 254 : 0;
#pragma unroll
      for (int w = 0; w < 2; ++w) {
        *(uint4*)(sd + (size_t)w * 5632 + ja) = *(const uint4*)(E + (tr + w) * 264 + cg * 8);
        *(uint4*)(sd + (size_t)w * 5632 + 2816 + ja) = *(const uint4*)(E + (tr + w) * 264 + 128 + cg * 8);
      }
    }
  }
  __syncthreads();
}

DI void up_fixup_tile(const P& p, int l, int lt) {
  const float* cw = p.conv_w + (size_t)l * 3 * 5632;
  const float* cb = p.conv_b + (size_t)l * 5632;
  const u16* sd = (const u16*)(p.ws + O_USIDE);
  const int ti = lt & 7;
  for (int e = tidx(); e < 2 * 2816; e += 512) {
    const int side = e >= 2816 ? 1 : 0, j = e - side * 2816;
    if ((side == 0 && ti == 0) || (side == 1 && ti == 7)) continue;
    const u16 *rm, *r0, *rp;
    if (side == 0) { rm = sd + ((size_t)(lt - 1) * 4 + 3) * 5632; r0 = sd + ((size_t)lt * 4 + 0) * 5632; rp = sd + ((size_t)lt * 4 + 1) * 5632; }
    else { rm = sd + ((size_t)lt * 4 + 2) * 5632; r0 = sd + ((size_t)lt * 4 + 3) * 5632; rp = sd + ((size_t)(lt + 1) * 4 + 0) * 5632; }
    const float a = cw[j] * bf2f(rm[j]) + cw[5632 + j] * bf2f(r0[j]) + cw[2 * 5632 + j] * bf2f(rp[j]) + cb[j];
    const float g = cw[2816 + j] * bf2f(rm[2816 + j]) + cw[5632 + 2816 + j] * bf2f(r0[2816 + j]) + cw[2 * 5632 + 2816 + j] * bf2f(rp[2816 + j]) + cb[2816 + j];
    const int tk = NTC + lt * 256 + (side ? 255 : 0);
    ((u16*)(p.ws + O_ACT))[(size_t)tk * 2816 + j] = f2bf(g * __builtin_amdgcn_rcpf(1.f + __expf(-g)) * a);
  }
  asm volatile("s_waitcnt vmcnt(0)" ::: "memory");
  __syncthreads();
}

#define XB_TMO      128
#define XB_XCNT(j)  (256  + 64 * (j))
#define XB_XSUB(j)  (1280 + 64 * (j))
#define XB_XGEN(j)  (2304 + 64 * (j))
#define XB_TOP      3328
#define XB_TOPGEN   3392
#define XCD_BAR_WORDS 3456
#define XB_SPIN_CAP (1u << 18)
DI unsigned xb_ld(unsigned* p) { return __hip_atomic_load(p, __ATOMIC_RELAXED, __HIP_MEMORY_SCOPE_AGENT); }
DI unsigned xb_add(unsigned* p, unsigned v) { return __hip_atomic_fetch_add(p, v, __ATOMIC_RELAXED, __HIP_MEMORY_SCOPE_AGENT); }
DI unsigned xb_xcc_id() { return (unsigned)__builtin_amdgcn_s_getreg((3 << 11) | 20) & 0xFu; }
#define XB_SPIN(cond, bar) do { unsigned _sp = 0; while (cond) { __builtin_amdgcn_s_sleep(1); \
    if ((++_sp & 255u) == 0u) { if (xb_ld(&(bar)[XB_TMO])) break; if (_sp > XB_SPIN_CAP) { atomicAdd(&(bar)[XB_TMO], 1u); break; } } } } while (0)
struct XcdBarrier { unsigned* bar; unsigned x; volatile LAS unsigned* st; };
DI XcdBarrier xcd_barrier_post(unsigned* bar, volatile LAS unsigned* st) {
  XcdBarrier b; b.bar = bar; b.x = xb_xcc_id(); b.st = st;
  if (threadIdx.x == 0) (void)xb_add(&bar[XB_XCNT(b.x)], 1u);
  return b;
}
DI void xcd_barrier_complete(unsigned* bar, unsigned x, unsigned& nloc, unsigned& nx) {
  const unsigned G = gridDim.x * gridDim.y * gridDim.z;
  unsigned sum, cnt, mine, sp = 0u;
  for (;;) {
    sum = 0u; cnt = 0u; mine = 0u;
#pragma unroll
    for (unsigned j = 0; j < 16; ++j) { const unsigned c = xb_ld(&bar[XB_XCNT(j)]); sum += c; cnt += (c > 0u) ? 1u : 0u; mine = (j == x) ? c : mine; }
    if (sum == G) break;
    __builtin_amdgcn_s_sleep(1);
    if ((++sp & 255u) == 0u) { if (xb_ld(&bar[XB_TMO])) break; if (sp > XB_SPIN_CAP) { atomicAdd(&bar[XB_TMO], 1u); break; } }
  }
  nloc = mine > 0u ? mine : 1u; nx = cnt > 0u ? cnt : 1u;
}
DI void xcd_barrier(const XcdBarrier& b) {
  asm volatile("s_waitcnt vmcnt(0)" ::: "memory");
  __syncthreads();
  if (threadIdx.x == 0) {
    unsigned* bar = b.bar;
    __builtin_amdgcn_s_waitcnt(0);
    unsigned nloc = b.st[0], nx = b.st[1];
    if (nloc == 0u) { xcd_barrier_complete(bar, b.x, nloc, nx); b.st[0] = nloc; b.st[1] = nx; }
    const unsigned old = xb_add(&bar[XB_XSUB(b.x)], 1u);
    const unsigned gen = old / nloc;
    if (old + 1u == (gen + 1u) * nloc) {
      __builtin_amdgcn_fence(__ATOMIC_RELEASE, "agent");
      asm volatile("s_waitcnt vmcnt(0)" ::: "memory");
      const unsigned og = xb_add(&bar[XB_TOP], 1u);
      const unsigned tg = og / nx;
      if (og + 1u == (tg + 1u) * nx) xb_add(&bar[XB_TOPGEN], 1u);
      else XB_SPIN(xb_ld(&bar[XB_TOPGEN]) == tg, bar);
      __builtin_amdgcn_fence(__ATOMIC_ACQUIRE, "agent");
      xb_add(&bar[XB_XGEN(b.x)], 1u);
      asm volatile("s_waitcnt vmcnt(0)" ::: "memory");
    } else {
      XB_SPIN(xb_ld(&bar[XB_XGEN(b.x)]) == gen, bar);
      __builtin_amdgcn_fence(__ATOMIC_ACQUIRE, "agent");
      asm volatile("s_waitcnt vmcnt(0)" ::: "memory");
    }
  }
  __syncthreads();
}

#define PFIELDS(X) X(x_prompt) X(x_sample) X(c) X(cgk) X(cgv) X(cnk) X(cnv) X(sre) X(sim) X(c_ctx) X(w_mod) X(b_mod) X(norm_g) X(w_in) X(qk_g) X(rpb) X(lam_re) \
  X(lam_im) X(log_step) X(b_re) X(b_im) X(c_re) X(c_im) X(ssm_d) X(w_glu) X(w_br_a) X(w_br_b) X(w_br_c) X(w_out) X(w_up) X(conv_w) X(conv_b) X(w_down)
DI void p_store(const P& p, volatile LAS unsigned* t) {
  int i = 0;
#define X(f) { const unsigned long long v_ = (unsigned long long)p.f; t[i] = (unsigned)v_; t[i + 1] = (unsigned)(v_ >> 32); i += 2; }
  PFIELDS(X)
#undef X
  { const unsigned long long v_ = (unsigned long long)p.out; t[i] = (unsigned)v_; t[i + 1] = (unsigned)(v_ >> 32); i += 2; }
  { const unsigned long long v_ = (unsigned long long)p.ws; t[i] = (unsigned)v_; t[i + 1] = (unsigned)(v_ >> 32); }
}
DI unsigned long long p_ld(volatile LAS unsigned* t, int i) {
  const unsigned lo = __builtin_amdgcn_readfirstlane(t[i]), hi = __builtin_amdgcn_readfirstlane(t[i + 1]);
  return ((unsigned long long)hi << 32) | lo;
}
DI P p_load(volatile LAS unsigned* t) {
  int i = 0;
#define X(f) const float* f##_ = (const float*)(const __attribute__((address_space(1))) float*)p_ld(t, i); i += 2;
  PFIELDS(X)
#undef X
  float* out_ = (float*)(__attribute__((address_space(1))) float*)p_ld(t, i); i += 2;
  char* ws_ = (char*)(__attribute__((address_space(1))) char*)p_ld(t, i);
  return P{
#define X(f) f##_,
  PFIELDS(X)
#undef X
  out_, ws_};
}
DI void run_phase(int ph, char* smem, const XcdBarrier& xb) {
  unsigned taddr = (unsigned)(SMEM_BYTES - 16 - 320);
  asm volatile("" : "+v"(taddr));
  const P p = p_load((volatile LAS unsigned*)(unsigned long long)taddr);
  const int G = gridDim.x, vb = vblock();
  char* ws = p.ws;
  if (ph == 0) { prep_layer0(p, smem); rope_table(p); if (DUPMASK & 0x1000) { xcd_barrier(xb); prep_layer0(p, smem); rope_table(p); } return; }
  if (ph == 1) { row_phase(p, 1 | 4, 0, 0, 0, nullptr, 0, 0, 0, 1); if (DUPMASK & 0x2000) { xcd_barrier(xb); row_phase(p, 1 | 4, 0, 0, 0, nullptr, 0, 0, 0, 1); } return; }
  const int l = (ph - 2) / 11, s = (ph - 2) % 11;
  const int nrep = ((DUPMASK >> s) & 1) ? 2 : 1;
  for (int rep = 0; rep < nrep; ++rep) {
    const bool dummy = (rep + 1 < nrep);
    if (rep > 0) xcd_barrier(xb);
    switch (s) {
      case 0: for (int it = vb; it < 96 * 11; it += G) inproj_tile(p, l, it, smem); break;
      case 1: for (int it = vb; it < 1024 + 192; it += G) { if (it < 1024) dense_item(p, it, smem, dummy); else s1_tile(p, it - 1024, smem); } break;
      case 2:
        for (int it = blockIdx.x; it < 320; it += G) scan_item(p, l, it);
        for (int it = vb; it < 512; it += G) na_item(p, l, it, smem, dummy);
        break;
      case 3: for (int it = vb; it < 192; it += G) s3_tile(p, l, it, smem); break;
      case 4: for (int it = vb; it < 192; it += G) glu_tile(p, it, smem); break;
      case 5: for (int it = vb; it < 384; it += G) merge_tile(p, it, smem);
              if (l == 0 && G == 256 && vb >= 128) for (int ci = NCONV_A + vb - 128; ci < NCONV; ci += 128) conv_item(p, 1, ci, smem);
              if (l == 0 && G != 256) for (int ci = NCONV_A + vb; ci < NCONV; ci += G) conv_item(p, 1, ci, smem);
              break;
      case 6: plain_phase<1024>((const u16*)(ws + O_MG), (const u16*)(ws + WT_OUT), (u16*)(ws + O_OB), vb, G, smem);
              if (l == 0) { if (G == 256) { if (vb >= 128 && vb < 160) ssm_tables(p, 1, vb - 128, smem); } else for (int ci = vb; ci < 32; ci += G) ssm_tables(p, 1, ci, smem); }
              break;
      case 7: row_phase(p, (l == 0 ? 1 : 0) | 2 | 4, l, 1, 2, (const u16*)(ws + O_OB), l, 2, 3, 4); break;
      case 8: for (int it = vb; it < 96 * 22; it += G) up_tile(p, l, it, smem);
              if (l == 0 && G == 256 && vb >= 64) for (int ci = vb - 64; ci < NCONV_A; ci += 192) conv_item(p, 1, ci, smem);
              if (l == 0 && G != 256) for (int ci = vb; ci < NCONV_A; ci += G) conv_item(p, 1, ci, smem);
              break;
      case 9:
        for (int it = vb; it < 384; it += G) {
          if ((it >> 2) >= 32) up_fixup_tile(p, l, (it >> 2) - 32);
          plain_tile<2816>((const u16*)(ws + O_ACT), (const u16*)(ws + (l ? WT_DN2 : WT_DN)), (u16*)(ws + O_F), (it >> 2) * 256, it & 3, smem);
        }
        break;
      case 10:
        if (l == 0) { row_phase(p, 2 | 4, 0, 3, 5, (const u16*)(ws + O_F), 1, 0, 0, 1); cache_convert(p, 1); }
        else row_phase(p, 2, 1, 3, 5, (const u16*)(ws + O_F), 0, 0, 0, 0);
        break;
    }
  }
}

__global__ void __launch_bounds__(512) mega(P p, int ph_lo, int ph_hi) {
  extern __shared__ __attribute__((aligned(16))) char smem[];
  volatile LAS unsigned* st = (volatile LAS unsigned*)((LAS char*)smem + (SMEM_BYTES - 16));
  if (threadIdx.x < 4) st[threadIdx.x] = 0u;
  if (threadIdx.x == 0) p_store(p, (volatile LAS unsigned*)((LAS char*)smem + (SMEM_BYTES - 16 - 320)));
  __syncthreads();
  const XcdBarrier xb = xcd_barrier_post((unsigned*)(p.ws + O_BAR), st);
  for (int ph = ph_lo; ph < ph_hi; ++ph) {
    run_phase(ph, smem, xb);
    if (ph + 1 < ph_hi) {
      if (ph == ph_lo) cg::this_grid().sync();
      else xcd_barrier(xb);
    }
  }
}

extern "C" void kernel_launch(void* const* d_in, const int* in_sizes, int n_in, void* d_out, int out_size, void* d_ws, size_t ws_size, hipStream_t stream) {
  P p{};
  const float** pp = (const float**)&p;
  for (int i = 0; i < 33; ++i) pp[i] = (const float*)d_in[i];
  p.out = (float*)d_out;
  p.ws = (char*)d_ws;
  static int grid_blocks = 0;
  if (!grid_blocks) {
    hipFuncSetAttribute((const void*)mega, hipFuncAttributeMaxDynamicSharedMemorySize, SMEM_BYTES);
    int dev = 0, cus = 0, per_cu = 0;
    hipGetDevice(&dev);
    hipDeviceGetAttribute(&cus, hipDeviceAttributeMultiprocessorCount, dev);
    hipOccupancyMaxActiveBlocksPerMultiprocessor(&per_cu, mega, 512, SMEM_BYTES);
    if (per_cu < 1) per_cu = 1;
    if (per_cu > 1) per_cu = 1;
    grid_blocks = cus * per_cu;
  }
  hipMemsetAsync((char*)d_ws + O_BAR, 0, XCD_BAR_WORDS * 4, stream);
#if SINGLE_LAUNCH
  int lo = 0, hi = NPHASE;
  void* args[] = {&p, &lo, &hi};
  hipError_t e = hipLaunchCooperativeKernel((void*)mega, dim3(grid_blocks), dim3(512), args, SMEM_BYTES, stream);
  if (e != hipSuccess) fprintf(stderr, "cooperative launch failed: %s (grid %d)\n", hipGetErrorString(e), grid_blocks);
#else
  for (int ph = 0; ph < NPHASE; ++ph) hipLaunchKernelGGL(mega, dim3(grid_blocks), dim3(512), SMEM_BYTES, stream, p, ph, ph + 1);
#endif
}
```

```cpp
#include <hip/hip_runtime.h>
#include <hip/hip_cooperative_groups.h>
#include <cstdio>
namespace cg = cooperative_groups;

#ifndef DUPMASK
#define DUPMASK 0
#endif
#ifndef SINGLE_LAUNCH
#define SINGLE_LAUNCH 1
#endif

typedef unsigned short u16;
typedef __attribute__((ext_vector_type(8))) short bf16x8;
typedef __attribute__((ext_vector_type(4))) float f32x4;
#define DI __device__ __forceinline__

constexpr int NT = 24576, NTC = 8192;
constexpr int NPHASE = 24;
constexpr int SMEM_BYTES = 135168 + 320 + 16;
constexpr int LDS_STAGE = 49152;

constexpr size_t O_MOD  = 0;
constexpr size_t O_ROPE = 524288;
constexpr size_t O_WT   = 1048576;
constexpr size_t WT_IN  = O_WT;
constexpr size_t WT_BR  = WT_IN + 12058624;
constexpr size_t WT_OUT = WT_BR + 3145728;
constexpr size_t WT_UP  = WT_OUT + 2097152;
constexpr size_t WT_DN  = WT_UP + 11534336;
constexpr size_t WT_GLU = WT_DN + 5767168;
constexpr size_t O_WST  = WT_GLU + 524288;
constexpr size_t O_WOUT = O_WST + 4194304;
constexpr size_t O_LAMT = O_WOUT + 8388608;
constexpr size_t O_USIDE= O_LAMT + 32768;
constexpr size_t O_H    = O_USIDE + 2883584;
constexpr size_t O_MIX  = O_H + 50331648;
constexpr size_t O_QGA  = O_MIX;
constexpr size_t O_UC   = O_MIX + 25165824;
constexpr size_t O_QNA  = O_MIX + 50331648;
constexpr size_t O_KGA  = O_MIX + 75497472;
constexpr size_t O_VTGA = O_KGA + 6815744;
constexpr size_t O_KNA  = O_VTGA + 6815744;
constexpr size_t O_VTNA = O_KNA + 27262976;
constexpr size_t O_SB   = O_MIX + 143654912;
constexpr size_t O_XIN  = O_SB + 25165824;
constexpr size_t O_ACT  = O_MIX;
constexpr size_t O_MG   = O_KGA;
constexpr size_t O_OB   = O_MIX;
constexpr size_t O_F    = O_H;
constexpr size_t O_BAR  = O_XIN + 25165824;
constexpr size_t WT_UP2 = O_BAR + 65536;
constexpr size_t WT_DN2 = WT_UP2 + 11534336;
constexpr size_t OUT_GAK = 25165824, OUT_GAV = 27262976, OUT_NAK = 29360128, OUT_NAV = 37748736, OUT_SRE = 46137344, OUT_SIM = 46399488;

struct P {
  const float *x_prompt, *x_sample, *c, *cgk, *cgv, *cnk, *cnv, *sre, *sim, *c_ctx, *w_mod, *b_mod, *norm_g, *w_in, *qk_g, *rpb,
      *lam_re, *lam_im, *log_step, *b_re, *b_im, *c_re, *c_im, *ssm_d, *w_glu, *w_br_a, *w_br_b, *w_br_c, *w_out, *w_up, *conv_w,
      *conv_b, *w_down;
  float* out;
  char* ws;
};

DI int tidx() { int t = threadIdx.x; asm volatile("" : "+v"(t)); return t; }
DI u16 f2bf(float f) { unsigned u = __float_as_uint(f); u += 0x7fffu + ((u >> 16) & 1u); return (u16)(u >> 16); }
DI float bf2f(unsigned h) { return __uint_as_float(h << 16); }
typedef float f32x2_t __attribute__((ext_vector_type(2)));
typedef __bf16 bf16x2_t __attribute__((ext_vector_type(2)));
DI unsigned pack2(float a, float b) { f32x2_t v = {a, b}; bf16x2_t r = __builtin_convertvector(v, bf16x2_t); return __builtin_bit_cast(unsigned, r); }
DI float bflo(unsigned u) { return __uint_as_float(u << 16); }
DI float bfhi(unsigned u) { return __uint_as_float(u & 0xffff0000u); }
DI void st_bf4(u16* p, float a, float b, float c, float d) { uint2 v; v.x = pack2(a, b); v.y = pack2(c, d); *(uint2*)p = v; }
DI float wave_sum(float v) {
#pragma unroll
  for (int o = 32; o; o >>= 1) v += __shfl_xor(v, o);
  return v;
}
DI float sigmoidf_(float x) { return __builtin_amdgcn_rcpf(1.f + __expf(-x)); }
DI int vblock() { int per = gridDim.x >> 3; return (gridDim.x & 7) ? (int)blockIdx.x : (int)((blockIdx.x & 7) * per + (blockIdx.x >> 3)); }

template <int NTB, class TF, class FF>
DI void gemm_acc(f32x4 (&acc)[4][NTB], TF trow, FF frow, int K, char* smem) {
  const int tid = tidx(), lane = tid & 63, wave = tid >> 6, wm = wave & 3, wn = wave >> 2;
  const int lr = tid >> 3, lc = tid & 7, l15 = lane & 15, q4 = lane >> 4;
  const u16* tp0 = trow(lr) + lc * 8;
  const u16* tp1 = trow(lr + 64) + lc * 8;
  const u16* tp2 = tp0;
  const u16* tp3 = tp0;
  if (NTB == 4) { tp2 = trow(lr + 128) + lc * 8; tp3 = trow(lr + 192) + lc * 8; }
  const u16* fp0 = frow(lr) + lc * 8;
  const u16* fp1 = frow(lr + 64) + lc * 8;
  const int wofs = lr * 128 + ((lc ^ (lr & 7)) << 4);
  uint4 t0 = *(const uint4*)tp0, t1 = *(const uint4*)tp1, t2 = t0, t3 = t0;
  if (NTB == 4) { t2 = *(const uint4*)tp2; t3 = *(const uint4*)tp3; }
  uint4 f0 = *(const uint4*)fp0, f1 = *(const uint4*)fp1;
  __syncthreads();
  *(uint4*)(smem + wofs) = t0; *(uint4*)(smem + wofs + 8192) = t1;
  if (NTB == 4) { *(uint4*)(smem + wofs + 16384) = t2; *(uint4*)(smem + wofs + 24576) = t3; }
  *(uint4*)(smem + 32768 + wofs) = f0; *(uint4*)(smem + 40960 + wofs) = f1;
  __syncthreads();
  const int nk = K >> 6;
  const int tro = (wm * (16 * NTB) + l15) * 128, fro = 32768 + (wn * 64 + l15) * 128, sw = l15 & 7;
#pragma unroll 1
  for (int kt = 0; kt < nk; ++kt) {
    const char* st = smem + (kt & 1) * LDS_STAGE;
    const bool more = (kt + 1 < nk);
    if (more) {
      const int ko = (kt + 1) * 64;
      t0 = *(const uint4*)(tp0 + ko); t1 = *(const uint4*)(tp1 + ko);
      if (NTB == 4) { t2 = *(const uint4*)(tp2 + ko); t3 = *(const uint4*)(tp3 + ko); }
      f0 = *(const uint4*)(fp0 + ko); f1 = *(const uint4*)(fp1 + ko);
    }
    __builtin_amdgcn_sched_barrier(0);
#pragma unroll
    for (int ks = 0; ks < 2; ++ks) {
      bf16x8 ff[4], tt[NTB];
      const int co = ((ks * 4 + q4) ^ sw) << 4;
#pragma unroll
      for (int i = 0; i < 4; ++i) ff[i] = *(const bf16x8*)(st + fro + i * 2048 + co);
#pragma unroll
      for (int i = 0; i < NTB; ++i) tt[i] = *(const bf16x8*)(st + tro + i * 2048 + co);
#pragma unroll
      for (int fb = 0; fb < 4; ++fb)
#pragma unroll
        for (int tb = 0; tb < NTB; ++tb) acc[fb][tb] = __builtin_amdgcn_mfma_f32_16x16x32_bf16(ff[fb], tt[tb], acc[fb][tb], 0, 0, 0);
      __builtin_amdgcn_sched_barrier(0);
    }
    if (more) {
      char* sn = smem + ((kt + 1) & 1) * LDS_STAGE;
      *(uint4*)(sn + wofs) = t0; *(uint4*)(sn + wofs + 8192) = t1;
      if (NTB == 4) { *(uint4*)(sn + wofs + 16384) = t2; *(uint4*)(sn + wofs + 24576) = t3; }
      *(uint4*)(sn + 32768 + wofs) = f0; *(uint4*)(sn + 40960 + wofs) = f1;
    }
    __syncthreads();
  }
}

#define ZERO_ACC(a) _Pragma("unroll") for (int i_ = 0; i_ < 4; ++i_) _Pragma("unroll") for (int j_ = 0; j_ < (int)(sizeof(a[0]) / sizeof(a[0][0])); ++j_) a[i_][j_] = f32x4{0.f, 0.f, 0.f, 0.f};

#define LAS __attribute__((address_space(3)))
constexpr int HTB = 16384;
DI int lds_byte(int r, int c) { const int st = (r >> 4) * 2 + (c >> 5), rr = r & 15, cc = c & 31, ob = rr * 64 + cc * 2; return st * 1024 + (ob ^ (((ob >> 9) & 1) << 5)); }
DI int perm32(int rho) { const int n = rho >> 4, i = rho & 15; return 8 * (i >> 2) + 4 * n + (i & 3); }
DI void stage_rc(int b, int& R, int& C) { const int st = b / 1024, sb = b % 1024, swz = sb ^ (((sb >> 9) & 1) << 5); R = (st >> 1) * 16 + swz / 64; C = (st & 1) * 32 + (swz % 64) / 2; }

DI void gemm256(LAS unsigned char* lds, const char* cA, size_t hstepA, unsigned voffA0, unsigned voffA1, const char* cB, size_t hstepB, unsigned voffB0, unsigned voffB1,
                int nt, f32x4 (&acc)[2][2][4][2], bool half = false) {
  const int tid = tidx(), wid = __builtin_amdgcn_readfirstlane(tid >> 6), lane = tid & 63, wr = wid >> 2, wc = wid & 3, fr = lane & 15, fq = lane >> 4;
  const size_t kstep = 128;
  const unsigned ldsw = (unsigned)wid * 1024u;
  const int aoff = lds_byte(wr * 64 + fr, fq * 8), boff = lds_byte(wc * 32 + fr, fq * 8);
#define G_SA(b, h) (((b) * 2 + (h)) * HTB)
#define G_SB(b, h) ((4 + (b) * 2 + (h)) * HTB)
#define G_STAGE(bufoff, gbase, v0, v1) do { \
    __builtin_amdgcn_global_load_lds((const unsigned*)((const char*)(gbase) + (v0)), (LAS unsigned*)(lds + (bufoff) + ldsw), 16, 0, 0); \
    __builtin_amdgcn_global_load_lds((const unsigned*)((const char*)(gbase) + (v1)), (LAS unsigned*)(lds + (bufoff) + ldsw + 8192), 16, 0, 0); } while (0)
#define G_STA(bufoff, gbase) G_STAGE(bufoff, gbase, voffA0, voffA1)
#define G_STB(bufoff, gbase) G_STAGE(bufoff, gbase, voffB0, voffB1)
#define G_LDA(dst, b, h) do { _Pragma("unroll") for (int m = 0; m < 4; ++m) _Pragma("unroll") for (int k = 0; k < 2; ++k) dst[m][k] = *(const LAS bf16x8*)(lds + G_SA(b, h) + aoff + m * 2048 + k * 1024); } while (0)
#define G_LDB(dst, b, h) do { _Pragma("unroll") for (int n = 0; n < 2; ++n) _Pragma("unroll") for (int k = 0; k < 2; ++k) dst[n][k] = *(const LAS bf16x8*)(lds + G_SB(b, h) + boff + n * 2048 + k * 1024); } while (0)
#define G_MMA(ai, bj, At, Bt) do { __builtin_amdgcn_s_setprio(1); _Pragma("unroll") for (int m = 0; m < 4; ++m) _Pragma("unroll") for (int n = 0; n < 2; ++n) _Pragma("unroll") for (int k = 0; k < 2; ++k) \
    acc[ai][bj][m][n] = __builtin_amdgcn_mfma_f32_16x16x32_bf16(Bt[n][k], At[m][k], acc[ai][bj][m][n], 0, 0, 0); __builtin_amdgcn_s_setprio(0); } while (0)
#define G_WAIT_V(n) asm volatile("s_waitcnt vmcnt(" #n ")" ::: "memory")
#define G_WAIT_L(n) asm volatile("s_waitcnt lgkmcnt(" #n ")" ::: "memory")
#define G_BAR __builtin_amdgcn_s_barrier()
#define G_SCHED __builtin_amdgcn_sched_barrier(0)
  bf16x8 At[4][2], B0[2][2], B1[2][2];
  G_STB(G_SB(0, 0), cB); G_STB(G_SB(0, 1), cB + hstepB); G_STA(G_SA(0, 0), cA); G_STA(G_SA(0, 1), cA + hstepA);
  if (wr == 1) G_BAR;
  G_WAIT_V(2); G_BAR;
  G_STB(G_SB(1, 0), cB + kstep); G_STA(G_SA(1, 0), cA + kstep); G_STB(G_SB(1, 1), cB + hstepB + kstep);
  G_WAIT_V(6); G_BAR;
#pragma unroll 1
  for (int t = 0; t < nt; t += 2) {
    const bool last = (t == nt - 2);
    const char* a1 = cA + (size_t)(t + 1) * kstep;
    const char* a2 = last ? cA : cA + (size_t)(t + 2) * kstep;
    const char* b2 = last ? cB : cB + (size_t)(t + 2) * kstep;
    const char* a3 = a2 + kstep;
    const char* b3 = b2 + kstep;
    G_LDB(B0, 0, 0); G_LDB(B1, 0, 1); G_SCHED; G_LDA(At, 0, 0); G_STA(G_SA(1, 1), a1 + hstepA);
    G_WAIT_V(8); G_WAIT_L(0); G_BAR; G_MMA(0, 0, At, B0); G_MMA(0, 1, At, B1); G_BAR; G_SCHED;
    G_LDA(At, 0, 1); G_STB(G_SB(0, 0), b2); G_STB(G_SB(0, 1), b2 + hstepB); G_STA(G_SA(0, 0), a2);
    G_WAIT_V(8); G_WAIT_L(0); G_BAR; if (!half) { G_MMA(1, 0, At, B0); G_MMA(1, 1, At, B1); } G_BAR; G_SCHED;
    G_LDB(B0, 1, 0); G_LDB(B1, 1, 1); G_SCHED; G_LDA(At, 1, 0); G_STA(G_SA(0, 1), a2 + hstepA);
    G_WAIT_V(8); G_WAIT_L(0); G_BAR; G_MMA(0, 0, At, B0); G_MMA(0, 1, At, B1); G_BAR; G_SCHED;
    G_LDA(At, 1, 1); G_STB(G_SB(1, 0), b3); G_STB(G_SB(1, 1), b3 + hstepB); G_STA(G_SA(1, 0), a3);
    G_WAIT_V(8); G_WAIT_L(0); G_BAR; if (!half) { G_MMA(1, 0, At, B0); G_MMA(1, 1, At, B1); } G_BAR; G_SCHED;
  }
  G_WAIT_V(0);
  if (wr == 0) G_BAR;
  G_BAR;
}
DI void gemm256c(LAS unsigned char* lds, const char* cA, size_t hstepA, const char* cB, size_t hstepB, int K, int nt, const char* nA, size_t nhA, const char* nB, size_t nhB, int nK,
                 bool has_next, bool first, bool lastcall, f32x4 (&acc)[2][2][4][2]) {
  const int tid = tidx(), wid = __builtin_amdgcn_readfirstlane(tid >> 6), lane = tid & 63, wr = wid >> 2, wc = wid & 3, fr = lane & 15, fq = lane >> 4;
  const size_t kstep = 128;
  const unsigned ldsw = (unsigned)wid * 1024u;
  const int aoff = lds_byte(wr * 64 + fr, fq * 8), boff = lds_byte(wc * 32 + fr, fq * 8);
  int R0, C0, R1, C1;
  stage_rc(tid * 16, R0, C0);
  stage_rc(tid * 16 + 8192, R1, C1);
  const unsigned voffA0 = (unsigned)(R0 * K + C0) * 2u, voffA1 = (unsigned)(R1 * K + C1) * 2u;
  const int RB0 = (R0 & ~31) + perm32(R0 & 31), RB1 = (R1 & ~31) + perm32(R1 & 31);
  const unsigned voffB0 = (unsigned)(RB0 * K + C0) * 2u, voffB1 = (unsigned)(RB1 * K + C1) * 2u;
  bf16x8 At[4][2], B0[2][2], B1[2][2];
  if (first) {
    G_STB(G_SB(0, 0), cB); G_STB(G_SB(0, 1), cB + hstepB); G_STA(G_SA(0, 0), cA); G_STA(G_SA(0, 1), cA + hstepA);
    if (wr == 1) G_BAR;
    G_WAIT_V(2); G_BAR;
    G_STB(G_SB(1, 0), cB + kstep); G_STA(G_SA(1, 0), cA + kstep); G_STB(G_SB(1, 1), cB + hstepB + kstep);
    G_WAIT_V(6); G_BAR;
  }
#pragma unroll 1
  for (int t = 0; t < nt; t += 2) {
    const bool tonext = (t == nt - 2) && has_next;
    const bool wrap = (t == nt - 2) && !has_next;
    const char* a1 = cA + (size_t)(t + 1) * kstep;
    const char* a2 = tonext ? nA : (wrap ? cA : cA + (size_t)(t + 2) * kstep);
    const char* b2 = tonext ? nB : (wrap ? cB : cB + (size_t)(t + 2) * kstep);
    const size_t hA2 = tonext ? nhA : hstepA, hB2 = tonext ? nhB : hstepB;
    const int K2 = tonext ? nK : K;
    const unsigned x0 = (unsigned)(R0 * K2 + C0) * 2u, x1 = (unsigned)(R1 * K2 + C1) * 2u, y0 = (unsigned)(RB0 * K2 + C0) * 2u, y1 = (unsigned)(RB1 * K2 + C1) * 2u;
    G_LDB(B0, 0, 0); G_LDB(B1, 0, 1); G_SCHED; G_LDA(At, 0, 0); G_STA(G_SA(1, 1), a1 + hstepA);
    G_WAIT_V(8); G_WAIT_L(0); G_BAR; G_MMA(0, 0, At, B0); G_MMA(0, 1, At, B1); G_BAR; G_SCHED;
    G_LDA(At, 0, 1); G_STAGE(G_SB(0, 0), b2, y0, y1); G_STAGE(G_SB(0, 1), b2 + hB2, y0, y1); G_STAGE(G_SA(0, 0), a2, x0, x1);
    G_WAIT_V(8); G_WAIT_L(0); G_BAR; G_MMA(1, 0, At, B0); G_MMA(1, 1, At, B1); G_BAR; G_SCHED;
    G_LDB(B0, 1, 0); G_LDB(B1, 1, 1); G_SCHED; G_LDA(At, 1, 0); G_STAGE(G_SA(0, 1), a2 + hA2, x0, x1);
    G_WAIT_V(8); G_WAIT_L(0); G_BAR; G_MMA(0, 0, At, B0); G_MMA(0, 1, At, B1); G_BAR; G_SCHED;
    G_LDA(At, 1, 1); G_STAGE(G_SB(1, 0), b2 + kstep, y0, y1); G_STAGE(G_SB(1, 1), b2 + kstep + hB2, y0, y1); G_STAGE(G_SA(1, 0), a2 + kstep, x0, x1);
    G_WAIT_V(8); G_WAIT_L(0); G_BAR; G_MMA(1, 0, At, B0); G_MMA(1, 1, At, B1); G_BAR; G_SCHED;
  }
  if (lastcall) {
    G_WAIT_V(0);
    if (wr == 0) G_BAR;
    G_BAR;
  }
}
#define ZERO_ACC8(a) _Pragma("unroll") for (int a_ = 0; a_ < 2; ++a_) _Pragma("unroll") for (int b_ = 0; b_ < 2; ++b_) _Pragma("unroll") for (int m_ = 0; m_ < 4; ++m_) \
    _Pragma("unroll") for (int n_ = 0; n_ < 2; ++n_) a[a_][b_][m_][n_] = f32x4{0.f, 0.f, 0.f, 0.f};
DI void voff_nat(int K, unsigned& v0, unsigned& v1) { const int tid = tidx(); int R, C; stage_rc(tid * 16, R, C); v0 = (unsigned)(R * K + C) * 2u; stage_rc(tid * 16 + 8192, R, C); v1 = (unsigned)(R * K + C) * 2u; }
DI void voff_perm(int K, unsigned& v0, unsigned& v1) { const int tid = tidx(); int R, C; stage_rc(tid * 16, R, C); v0 = (unsigned)(((R & ~31) + perm32(R & 31)) * K + C) * 2u;
  stage_rc(tid * 16 + 8192, R, C); v1 = (unsigned)(((R & ~31) + perm32(R & 31)) * K + C) * 2u; }
DI void st_bf8(u16* p, const f32x4& a, const f32x4& b) { uint4 v; v.x = pack2(a[0], a[1]); v.y = pack2(a[2], a[3]); v.z = pack2(b[0], b[1]); v.w = pack2(b[2], b[3]); *(uint4*)p = v; }
DI void voff_grp(int K, unsigned& v0, unsigned& v1) { const int tid = tidx(); int R, C; stage_rc(tid * 16, R, C); v0 = (unsigned)((64 * (R >> 5) + (R & 31)) * K + C) * 2u;
  stage_rc(tid * 16 + 8192, R, C); v1 = (unsigned)((64 * (R >> 5) + (R & 31)) * K + C) * 2u; }

DI void mod_item(const P& p, int it, char* smem) {
  float* sc = (float*)smem;
  float* red = sc + 9 * 1024;
  const int tid = tidx(), lane = tid & 63, wave = tid >> 6;
  const int l = it / 96, jb = (it % 96) * 64;
  const float* pc_ctx = p.c_ctx;
  const float* pc_lat = p.c;
  __syncthreads();
  for (int e = tid; e < 9 * 1024; e += 512) {
    int mi = e >> 10, k = e & 1023;
    const float* cp = mi == 0 ? pc_ctx + k : pc_lat + (mi - 1) * 1024 + k;
    float v = *cp;
    sc[e] = v * __builtin_amdgcn_rcpf(1.f + __expf(-v));
  }
  __syncthreads();
  float a[9];
#pragma unroll
  for (int i = 0; i < 9; ++i) a[i] = 0.f;
  const float* w = p.w_mod + (size_t)l * 1024 * 6144 + jb + lane;
  for (int k = wave * 128; k < wave * 128 + 128; k += 4) {
    const float w0 = w[(size_t)k * 6144], w1 = w[(size_t)(k + 1) * 6144], w2 = w[(size_t)(k + 2) * 6144], w3 = w[(size_t)(k + 3) * 6144];
#pragma unroll
    for (int i = 0; i < 9; ++i) {
      const float4 sv = *(const float4*)(sc + i * 1024 + k);
      a[i] += w0 * sv.x + w1 * sv.y + w2 * sv.z + w3 * sv.w;
    }
  }
#pragma unroll
  for (int i = 0; i < 9; ++i) red[(wave * 9 + i) * 64 + lane] = a[i];
  __syncthreads();
  float* mod = (float*)(p.ws + O_MOD);
  for (int e = tid; e < 576; e += 512) {
    int mi = e >> 6, ln = e & 63;
    float s = 0.f;
#pragma unroll
    for (int wv = 0; wv < 8; ++wv) s += red[(wv * 9 + mi) * 64 + ln];
    mod[(size_t)(l * 9 + mi) * 6144 + jb + ln] = s + p.b_mod[l * 6144 + jb + ln];
  }
}

DI void conv_tile(const float* src, int ld, int K, u16* dst, int kt, int nt, char* smem) {
  float* tl = (float*)smem;
  const int tid = tidx();
  __syncthreads();
  float v[32];
#pragma unroll
  for (int i = 0; i < 32; ++i) { const int e = tid + i * 512; v[i] = src[(size_t)(kt * 64 + (e >> 8)) * ld + nt * 256 + (e & 255)]; }
#pragma unroll
  for (int i = 0; i < 32; ++i) { const int e = tid + i * 512; tl[(e >> 8) * 257 + (e & 255)] = v[i]; }
  __syncthreads();
#pragma unroll
  for (int j = 0; j < 4; ++j) {
    const int c = tid + j * 512, n = c >> 3, kc = (c & 7) * 8;
    uint4 o;
    o.x = pack2(tl[(kc + 0) * 257 + n], tl[(kc + 1) * 257 + n]);
    o.y = pack2(tl[(kc + 2) * 257 + n], tl[(kc + 3) * 257 + n]);
    o.z = pack2(tl[(kc + 4) * 257 + n], tl[(kc + 5) * 257 + n]);
    o.w = pack2(tl[(kc + 6) * 257 + n], tl[(kc + 7) * 257 + n]);
    *(uint4*)(dst + (size_t)(nt * 256 + n) * K + kt * 64 + kc) = o;
  }
}
constexpr int NCONV_A = 544, NCONV = 1072;
DI void conv_item(const P& p, int l, int it, char* smem) {
  char* ws = p.ws;
  const float *s_in = p.w_in, *s_a = p.w_br_a, *s_b = p.w_br_b, *s_c = p.w_br_c, *s_out = p.w_out, *s_up = p.w_up, *s_dn = p.w_down, *s_glu = p.w_glu;
  const float* src; int ld, K, kt, nt; u16* dst;
  if (it < 368) { src = s_in + (size_t)l * 1024 * 5888; ld = 5888; K = 1024; dst = (u16*)(ws + WT_IN); kt = it & 15; nt = it >> 4; }
  else if (it < 464) {
    it -= 368;
    int br = it >> 5, r = it & 31;
    src = (br == 0 ? s_a : br == 1 ? s_b : s_c) + (size_t)l * 512 * 1024; ld = 1024; K = 512; dst = (u16*)(ws + WT_BR) + (size_t)br * 1024 * 512; kt = r & 7; nt = r >> 3;
  } else if (it < 528) { it -= 464; src = s_out + (size_t)l * 1024 * 1024; ld = 1024; K = 1024; dst = (u16*)(ws + WT_OUT); kt = it & 15; nt = it >> 4; }
  else if (it < 544) { it -= 528; src = s_glu + (size_t)l * 512 * 512; ld = 512; K = 512; dst = (u16*)(ws + WT_GLU); kt = it & 7; nt = it >> 3; }
  else if (it < 896) { it -= 544; src = s_up + (size_t)l * 1024 * 5632; ld = 5632; K = 1024; dst = (u16*)(ws + (l ? WT_UP2 : WT_UP)); kt = it & 15; nt = it >> 4; }
  else { it -= 896; src = s_dn + (size_t)l * 2816 * 1024; ld = 1024; K = 2816; dst = (u16*)(ws + (l ? WT_DN2 : WT_DN)); kt = it % 44; nt = it / 44; }
  conv_tile(src, ld, K, dst, kt, nt, smem);
}

DI float2 cmul(float2 a, float2 b) { return make_float2(a.x * b.x - a.y * b.y, a.x * b.y + a.y * b.x); }
DI void ssm_tables(const P& p, int l, int g, char* smem) {
  float2* pw = (float2*)smem;
  float2* bb = pw + 2 * 17 * 64;
  float2* cc = bb + 2048;
  float* kl = (float*)(cc + 2048);
  const int tid = tidx();
  __syncthreads();
  for (int e = tid; e < 2 * 17 * 64; e += 512) {
    int d = e / (17 * 64), r = e % (17 * 64), ee = r >> 6, pp = r & 63;
    int li = ((l * 2 + d) * 32 + g) * 64 + pp;
    float lr_ = p.lam_re[li], lim = p.lam_im[li], dt = expf(p.log_step[(l * 2 + d) * 32 + g]);
    float mag = expf((float)ee * (lr_ * dt)), s, c;
    sincosf((float)ee * (lim * dt), &s, &c);
    pw[e] = make_float2(mag * c, mag * s);
  }
  for (int e = tid; e < 2048; e += 512) {
    int d = e >> 10, h = (e >> 6) & 15, pp = e & 63;
    int ci = (((l * 2 + d) * 32 + g) * 16 + h) * 64 + pp;
    cc[e] = make_float2(p.c_re[ci], p.c_im[ci]);
  }
  __syncthreads();
  for (int e = tid; e < 2048; e += 512) {
    int d = e >> 10, pp = (e >> 4) & 63, h = e & 15;
    int li = ((l * 2 + d) * 32 + g) * 64 + pp;
    float lr_ = p.lam_re[li], lim = p.lam_im[li];
    float2 lb = pw[(d * 17 + 1) * 64 + pp];
    float nr = lb.x - 1.f, ni = lb.y, den = lr_ * lr_ + lim * lim;
    float2 q = make_float2((nr * lr_ + ni * lim) / den, (ni * lr_ - nr * lim) / den);
    float2 b = make_float2(p.b_re[(size_t)li * 16 + h], p.b_im[(size_t)li * 16 + h]);
    bb[e] = cmul(q, b);
  }
  __syncthreads();
  for (int e = tid; e < 31 * 256; e += 512) {
    int lg = e >> 8, h = (e >> 4) & 15, h2 = e & 15, lag = lg - 15;
    float s = 0.f;
    if (lag >= 0)
      for (int pp = 0; pp < 64; ++pp) {
        float2 cw = cmul(cc[(0 * 16 + h) * 64 + pp], pw[(0 * 17 + lag) * 64 + pp]);
        float2 b = bb[(0 * 64 + pp) * 16 + h2];
        s += cw.x * b.x - cw.y * b.y;
      }
    if (lag <= 0)
      for (int pp = 0; pp < 64; ++pp) {
        float2 cw = cmul(cc[(1 * 16 + h) * 64 + pp], pw[(1 * 17 - lag) * 64 + pp]);
        float2 b = bb[(1 * 64 + pp) * 16 + h2];
        s += cw.x * b.x - cw.y * b.y;
      }
    kl[e] = s;
  }
  __syncthreads();
  u16* wout = (u16*)(p.ws + O_WOUT) + (size_t)g * 256 * 512;
  for (int c = tid; c < 16384; c += 512) {
    int n = c >> 6, kc = (c & 63) * 8, t = n >> 4, h = n & 15;
    float v[8];
#pragma unroll
    for (int i = 0; i < 8; ++i) {
      int k = kc + i;
      if (kc < 256) {
        int s = k >> 4, h2 = k & 15;
        v[i] = kl[(t - s + 15) * 256 + h * 16 + h2];
      } else {
        int d = (kc >= 384) ? 1 : 0, kk = k - 256 - d * 128, pp = kk >> 1, ri = kk & 1, e = d ? 16 - t : t + 1;
        float2 cl = cmul(cc[(d * 16 + h) * 64 + pp], pw[(d * 17 + e) * 64 + pp]);
        v[i] = ri ? -cl.y : cl.x;
      }
    }
    uint4 o; o.x = pack2(v[0], v[1]); o.y = pack2(v[2], v[3]); o.z = pack2(v[4], v[5]); o.w = pack2(v[6], v[7]);
    *(uint4*)(wout + (size_t)n * 512 + kc) = o;
  }
  u16* wst = (u16*)(p.ws + O_WST) + (size_t)g * 256 * 256;
  for (int c = tid; c < 8192; c += 512) {
    int n = c >> 5, kc = (c & 31) * 8, d = n >> 7, pp = (n >> 1) & 63, ri = n & 1;
    float v[8];
#pragma unroll
    for (int i = 0; i < 8; ++i) {
      int k = kc + i, s = k >> 4, h2 = k & 15, e = d ? s : 15 - s;
      float2 z = cmul(pw[(d * 17 + e) * 64 + pp], bb[(d * 64 + pp) * 16 + h2]);
      v[i] = ri ? z.y : z.x;
    }
    uint4 o; o.x = pack2(v[0], v[1]); o.y = pack2(v[2], v[3]); o.z = pack2(v[4], v[5]); o.w = pack2(v[6], v[7]);
    *(uint4*)(wst + (size_t)n * 256 + kc) = o;
  }
  if (tid < 128) {
    int d = tid >> 6, pp = tid & 63;
    ((float2*)(p.ws + O_LAMT))[(d * 32 + g) * 64 + pp] = pw[(d * 17 + 16) * 64 + pp];
  }
}

DI void cache_convert(const P& p, int l) {
  const int gsz = gridDim.x * 512, gid = blockIdx.x * 512 + tidx();
  u16* kga = (u16*)(p.ws + O_KGA) + 1048576; u16* vtga = (u16*)(p.ws + O_VTGA) + 1048576;
  u16* kna = (u16*)(p.ws + O_KNA) + 4194304; u16* vtna = (u16*)(p.ws + O_VTNA) + 4194304;
  const float *cgk = p.cgk, *cgv = p.cgv, *cnk = p.cnk, *cnv = p.cnv;
  for (int idx = gid; idx < 32768 + 131072; idx += gsz) {
    const bool ga = idx < 32768;
    const int id = ga ? idx : idx - 32768, NH = ga ? 2 : 8;
    const int t = id & 255, dc = (id >> 8) & 7, bh = id >> 11, head = bh % NH, b = bh / NH;
    const size_t so = ((((size_t)b * 2 + l) * 256 + t) * NH + head) * 64 + dc * 8;
    const float* ks = (ga ? cgk : cnk) + so;
    const float* vs = (ga ? cgv : cnv) + so;
    float4 k0 = *(const float4*)ks, k1 = *(const float4*)(ks + 4), v0 = *(const float4*)vs, v1 = *(const float4*)(vs + 4);
    u16* kd = (ga ? kga : kna) + ((size_t)bh * 2304 + 2048 + t) * 64 + dc * 8;
    uint4 o; o.x = pack2(k0.x, k0.y); o.y = pack2(k0.z, k0.w); o.z = pack2(k1.x, k1.y); o.w = pack2(k1.z, k1.w);
    *(uint4*)kd = o;
    u16* vd = (ga ? vtga : vtna) + ((size_t)bh * 64 + dc * 8) * 2304 + 2048 + t;
    vd[0] = f2bf(v0.x); vd[2304] = f2bf(v0.y); vd[2 * 2304] = f2bf(v0.z); vd[3 * 2304] = f2bf(v0.w);
    vd[4 * 2304] = f2bf(v1.x); vd[5 * 2304] = f2bf(v1.y); vd[6 * 2304] = f2bf(v1.z); vd[7 * 2304] = f2bf(v1.w);
  }
}

DI void prep_layer0(const P& p, char* smem) {
  const int G = gridDim.x, b = blockIdx.x;
  if (G >= 64) {
    if (b < 32) ssm_tables(p, 0, b, smem);
    else
      for (int it = b - 32; it < 192 + NCONV; it += G - 32) {
        if (it < 192) mod_item(p, it, smem);
        else conv_item(p, 0, it - 192, smem);
      }
  } else {
    for (int it = b; it < 32 + 192 + NCONV; it += G) {
      if (it < 32) ssm_tables(p, 0, it, smem);
      else if (it < 224) mod_item(p, it - 32, smem);
      else conv_item(p, 0, it - 224, smem);
    }
  }
  cache_convert(p, 0);
}

DI void rope_table(const P& p) {
  float2* rt = (float2*)(p.ws + O_ROPE);
  for (int e = blockIdx.x * 512 + tidx(); e < 2048 * 32; e += gridDim.x * 512) {
    int t = e >> 5, a = (e >> 4) & 1, f = e & 15;
    float pos = (float)(a ? (t & 63) : (t >> 6));
    float inv = powf(10000.f, -(float)f / 16.f);
    float s, c;
    sincosf(pos * inv, &s, &c);
    rt[e] = make_float2(c, s);
  }
}

DI void row_phase(const P& p, int flags, int lr, int gi_r, int gt_idx, const u16* R, int lh, int gi_h, int sh_idx, int sc_idx, bool nostore = false) {
  const int lane = tidx() & 63, wave = tidx() >> 6;
  const float* mod = (const float*)(p.ws + O_MOD);
  u16* H = (u16*)(p.ws + O_H);
  const float *xp = p.x_prompt, *xsm = p.x_sample;
  float* xo = p.out;
  const float* ng = p.norm_g;
  const int nw = gridDim.x * 8, rpw = (NT + nw - 1) / nw, w = blockIdx.x * 8 + wave;
  const int rbeg = w * rpw, rend = min(NT, rbeg + rpw);
  float4 gR[4], gtv[4], gH[4], scv[4], shv[4];
  int cur_mi = -1;
  float4 xn[4];
  uint2 rn[4];
#define ROW_LOAD(row_) do { \
    const float* xs_ = (flags & 1) ? ((row_) < NTC ? xp + (size_t)(row_) * 1024 : xsm + (size_t)((row_) - NTC) * 1024) : xo + (size_t)(row_) * 1024; \
    _Pragma("unroll") for (int i = 0; i < 4; ++i) xn[i] = *(const float4*)(xs_ + i * 256 + lane * 4); \
    if (flags & 2) { _Pragma("unroll") for (int i = 0; i < 4; ++i) rn[i] = *(const uint2*)(R + (size_t)(row_) * 1024 + i * 256 + lane * 4); } } while (0)
  if (rbeg < rend) ROW_LOAD(rbeg);
  for (int row = rbeg; row < rend; ++row) {
    const int mi = row < NTC ? 0 : 1 + ((row - NTC) >> 11);
    if (mi != cur_mi) {
      cur_mi = mi;
      if (flags & 2) {
        const float* g = ng + (lr * 4 + gi_r) * 1024;
        const float* gt = mod + ((size_t)(lr * 9 + mi) * 6 + gt_idx) * 1024;
#pragma unroll
        for (int i = 0; i < 4; ++i) { gR[i] = *(const float4*)(g + i * 256 + lane * 4); gtv[i] = *(const float4*)(gt + i * 256 + lane * 4); }
      }
      if (flags & 4) {
        const float* g = ng + (lh * 4 + gi_h) * 1024;
        const float* sh = mod + ((size_t)(lh * 9 + mi) * 6 + sh_idx) * 1024;
        const float* sc = mod + ((size_t)(lh * 9 + mi) * 6 + sc_idx) * 1024;
#pragma unroll
        for (int i = 0; i < 4; ++i) { gH[i] = *(const float4*)(g + i * 256 + lane * 4); scv[i] = *(const float4*)(sc + i * 256 + lane * 4); shv[i] = *(const float4*)(sh + i * 256 + lane * 4); }
      }
    }
    float4 x[4];
    uint2 rcur[4];
#pragma unroll
    for (int i = 0; i < 4; ++i) { x[i] = xn[i]; rcur[i] = rn[i]; }
    if (row + 1 < rend) ROW_LOAD(row + 1);
    if (flags & 2) {
      float r[4][4];
      float ssq = 0.f;
#pragma unroll
      for (int i = 0; i < 4; ++i) {
        const uint2 rv = rcur[i];
        r[i][0] = bflo(rv.x); r[i][1] = bfhi(rv.x); r[i][2] = bflo(rv.y); r[i][3] = bfhi(rv.y);
        ssq += r[i][0] * r[i][0] + r[i][1] * r[i][1] + r[i][2] * r[i][2] + r[i][3] * r[i][3];
      }
      ssq = wave_sum(ssq);
      const float rstd = rsqrtf(ssq * (1.f / 1024.f) + 1e-6f);
#pragma unroll
      for (int i = 0; i < 4; ++i) {
        x[i].x += gtv[i].x * (r[i][0] * rstd * gR[i].x); x[i].y += gtv[i].y * (r[i][1] * rstd * gR[i].y);
        x[i].z += gtv[i].z * (r[i][2] * rstd * gR[i].z); x[i].w += gtv[i].w * (r[i][3] * rstd * gR[i].w);
        if (!nostore || rstd == -1.f) *(float4*)(xo + (size_t)row * 1024 + i * 256 + lane * 4) = x[i];
      }
    }
    if (flags & 4) {
      float ssq = 0.f;
#pragma unroll
      for (int i = 0; i < 4; ++i) ssq += x[i].x * x[i].x + x[i].y * x[i].y + x[i].z * x[i].z + x[i].w * x[i].w;
      ssq = wave_sum(ssq);
      const float rstd = rsqrtf(ssq * (1.f / 1024.f) + 1e-6f);
#pragma unroll
      for (int i = 0; i < 4; ++i) {
        if (!nostore || rstd == -1.f)
          st_bf4(H + (size_t)row * 1024 + i * 256 + lane * 4, x[i].x * rstd * gH[i].x * (1.f + scv[i].x) + shv[i].x, x[i].y * rstd * gH[i].y * (1.f + scv[i].y) + shv[i].y,
                 x[i].z * rstd * gH[i].z * (1.f + scv[i].z) + shv[i].z, x[i].w * rstd * gH[i].w * (1.f + scv[i].w) + shv[i].w);
      }
    }
  }
#undef ROW_LOAD
}

DI void inproj_tile(const P& p, int l, int it, char* smem) {
  const int pm = it / 11, pn = it % 11, m0 = pm * 256;
  const int tid = tidx(), lane = tid & 63, wave = tid >> 6, wr = wave >> 2, wc = wave & 3, l15 = lane & 15, q4 = lane >> 4;
  f32x4 acc8[2][2][4][2];
  ZERO_ACC8(acc8);
  {
    unsigned va0, va1, vb0, vb1;
    voff_nat(1024, va0, va1);
    voff_grp(1024, vb0, vb1);
    gemm256((LAS unsigned char*)smem, (const char*)(p.ws + O_H) + (size_t)m0 * 2048, (size_t)128 * 2048, va0, va1, (const char*)(p.ws + WT_IN) + (size_t)pn * 256 * 2048, (size_t)32 * 2048,
            vb0, vb1, 16, acc8);
  }
  const int nb = pn * 256 + wc * 64;
  const bool lat = m0 >= NTC;
  char* ws = p.ws;
#pragma unroll
  for (int tb = 0; tb < 8; ++tb) {
    const int tk = m0 + (tb >> 2) * 128 + wr * 64 + (tb & 3) * 16 + l15;
    int b, t;
    if (!lat) { b = tk >> 8; t = tk & 255; } else { b = (tk - NTC) >> 11; t = (tk - NTC) & 2047; }
    float v[4][4];
#pragma unroll
    for (int fb = 0; fb < 4; ++fb)
#pragma unroll
      for (int j = 0; j < 4; ++j) v[fb][j] = acc8[tb >> 2][fb >> 1][tb & 3][fb & 1][j];
    if (nb < 640) {
      float ssq = 0.f;
#pragma unroll
      for (int fb = 0; fb < 4; ++fb)
#pragma unroll
        for (int j = 0; j < 4; ++j) ssq += v[fb][j] * v[fb][j];
      ssq += __shfl_xor(ssq, 16);
      ssq += __shfl_xor(ssq, 32);
      const float rstd = rsqrtf(ssq * (1.f / 64.f) + 1e-6f);
      const float* g = p.qk_g + (l * 2 + (nb >= 512 ? 1 : 0)) * 64;
#pragma unroll
      for (int fb = 0; fb < 4; ++fb) {
        float4 gv = *(const float4*)(g + fb * 16 + q4 * 4);
        v[fb][0] *= rstd * gv.x; v[fb][1] *= rstd * gv.y; v[fb][2] *= rstd * gv.z; v[fb][3] *= rstd * gv.w;
      }
      if (nb >= 512 && !lat) {
        float* o = p.out + OUT_GAK + (((size_t)(b * 2 + l) * 256 + t) * 2 + ((nb - 512) >> 6)) * 64 + q4 * 4;
#pragma unroll
        for (int fb = 0; fb < 4; ++fb) *(float4*)(o + fb * 16) = make_float4(v[fb][0], v[fb][1], v[fb][2], v[fb][3]);
      }
      if (lat) {
        const float2* rt = (const float2*)(ws + O_ROPE) + t * 32 + q4 * 4;
#pragma unroll
        for (int a = 0; a < 2; ++a)
          {
            const float4 c01 = *(const float4*)(rt + a * 16), c23 = *(const float4*)(rt + a * 16 + 2);
            const float cc[4] = {c01.x, c01.z, c23.x, c23.z}, sn[4] = {c01.y, c01.w, c23.y, c23.w};
#pragma unroll
            for (int j = 0; j < 4; ++j) {
              const float x1 = v[2 * a][j], x2 = v[2 * a + 1][j];
              v[2 * a][j] = x1 * cc[j] - x2 * sn[j];
              v[2 * a + 1][j] = x1 * sn[j] + x2 * cc[j];
            }
          }
      }
      if (nb < 512) {
        u16* o = (u16*)(ws + O_QGA) + (size_t)tk * 512 + nb + q4 * 4;
#pragma unroll
        for (int fb = 0; fb < 4; ++fb) st_bf4(o + fb * 16, v[fb][0], v[fb][1], v[fb][2], v[fb][3]);
      } else {
        const int kvh = (nb - 512) >> 6;
        u16* o = lat ? (u16*)(ws + O_KGA) + 1048576 + ((size_t)(b * 2 + kvh) * 2304 + t) * 64 : (u16*)(ws + O_KGA) + ((size_t)(b * 2 + kvh) * 256 + t) * 64;
#pragma unroll
        for (int fb = 0; fb < 4; ++fb) st_bf4(o + fb * 16 + q4 * 4, v[fb][0], v[fb][1], v[fb][2], v[fb][3]);
      }
    } else if (nb < 768) {
      const int kvh = (nb - 640) >> 6;
      if (!lat) {
        float* o = p.out + OUT_GAV + (((size_t)(b * 2 + l) * 256 + t) * 2 + kvh) * 64 + q4 * 4;
#pragma unroll
        for (int fb = 0; fb < 4; ++fb) *(float4*)(o + fb * 16) = make_float4(v[fb][0], v[fb][1], v[fb][2], v[fb][3]);
      }
      const int st = lat ? 2304 : 256;
      u16* o = lat ? (u16*)(ws + O_VTGA) + 1048576 + ((size_t)(b * 2 + kvh) * 64) * 2304 + t : (u16*)(ws + O_VTGA) + ((size_t)(b * 2 + kvh) * 64) * 256 + t;
#pragma unroll
      for (int fb = 0; fb < 4; ++fb)
#pragma unroll
        for (int j = 0; j < 4; ++j) o[(size_t)(fb * 16 + q4 * 4 + j) * st] = f2bf(v[fb][j]);
    } else if (nb < 1280) {
      const int g0 = (nb - 768) >> 4;
      u16* o = (u16*)(ws + O_UC) + ((size_t)(tk >> 4)) * 256 + (tk & 15) * 16 + q4 * 4;
#pragma unroll
      for (int fb = 0; fb < 4; ++fb) st_bf4(o + (size_t)(g0 + fb) * 1536 * 256, v[fb][0], v[fb][1], v[fb][2], v[fb][3]);
    } else if (nb < 1792) {
      u16* o = (u16*)(ws + O_QNA) + (size_t)tk * 512 + (nb - 1280) + q4 * 4;
#pragma unroll
      for (int fb = 0; fb < 4; ++fb) st_bf4(o + fb * 16, v[fb][0], v[fb][1], v[fb][2], v[fb][3]);
    } else if (nb < 2304) {
      const int h = (nb - 1792) >> 6;
      if (!lat) {
        float* o = p.out + OUT_NAK + (((size_t)(b * 2 + l) * 256 + t) * 8 + h) * 64 + q4 * 4;
#pragma unroll
        for (int fb = 0; fb < 4; ++fb) *(float4*)(o + fb * 16) = make_float4(v[fb][0], v[fb][1], v[fb][2], v[fb][3]);
      }
      u16* o = lat ? (u16*)(ws + O_KNA) + 4194304 + ((size_t)(b * 8 + h) * 2304 + t) * 64 : (u16*)(ws + O_KNA) + ((size_t)(b * 8 + h) * 256 + t) * 64;
#pragma unroll
      for (int fb = 0; fb < 4; ++fb) st_bf4(o + fb * 16 + q4 * 4, v[fb][0], v[fb][1], v[fb][2], v[fb][3]);
    } else {
      const int h = (nb - 2304) >> 6;
      if (!lat) {
        float* o = p.out + OUT_NAV + (((size_t)(b * 2 + l) * 256 + t) * 8 + h) * 64 + q4 * 4;
#pragma unroll
        for (int fb = 0; fb < 4; ++fb) *(float4*)(o + fb * 16) = make_float4(v[fb][0], v[fb][1], v[fb][2], v[fb][3]);
      }
      const int st = lat ? 2304 : 256;
      u16* o = lat ? (u16*)(ws + O_VTNA) + 4194304 + ((size_t)(b * 8 + h) * 64) * 2304 + t : (u16*)(ws + O_VTNA) + ((size_t)(b * 8 + h) * 64) * 256 + t;
#pragma unroll
      for (int fb = 0; fb < 4; ++fb)
#pragma unroll
        for (int j = 0; j < 4; ++j) o[(size_t)(fb * 16 + q4 * 4 + j) * st] = f2bf(v[fb][j]);
    }
  }
}

template <int NQ, int MODE>
DI void attn_block(const u16* Kb, const u16* VTb, int vt_stride, int n1, int base1, int base2, int ntiles,
                           const u16* qp, u16* op, int qstride_blk, char* smem,
                           int na_r, int na_col, int na_rlo, const float* rpbs) {
  const int tid = tidx(), lane = tid & 63, l15 = lane & 15, q4 = lane >> 4, sw = l15 & 7;
  bf16x8 qf[NQ][2];
#pragma unroll
  for (int qb = 0; qb < NQ; ++qb)
#pragma unroll
    for (int ks = 0; ks < 2; ++ks) qf[qb][ks] = *(const bf16x8*)(qp + (size_t)qb * qstride_blk + ks * 32 + q4 * 8);
  f32x4 o[4][NQ];
  float m[NQ];
  f32x4 osum[NQ];
  const uint4 ones_u = {0x3F803F80u, 0x3F803F80u, 0x3F803F80u, 0x3F803F80u};
  const bf16x8 ones = __builtin_bit_cast(bf16x8, ones_u);
#pragma unroll
  for (int qb = 0; qb < NQ; ++qb) {
    m[qb] = -1e30f; osum[qb] = f32x4{0.f, 0.f, 0.f, 0.f};
#pragma unroll
    for (int db = 0; db < 4; ++db) o[db][qb] = f32x4{0.f, 0.f, 0.f, 0.f};
  }
  const int ldr = tid >> 3, ldc = tid & 7;
  const int wofs = ldr * 128 + ((ldc ^ (ldr & 7)) << 4);
  const int vofs = 8192 + ldr * 144 + ldc * 16;
  uint4 kr0, vr0, kr1, vr1;
  {
    const int k0 = (0 < n1) ? base1 : base2;
    kr0 = *(const uint4*)(Kb + (size_t)(k0 + ldr) * 64 + ldc * 8);
    vr0 = *(const uint4*)(VTb + (size_t)ldr * vt_stride + k0 + ldc * 8);
    kr1 = kr0; vr1 = vr0;
    if (1 < ntiles) {
      const int k1 = (1 < n1) ? base1 + 64 : base2 + (1 - n1) * 64;
      kr1 = *(const uint4*)(Kb + (size_t)(k1 + ldr) * 64 + ldc * 8);
      vr1 = *(const uint4*)(VTb + (size_t)ldr * vt_stride + k1 + ldc * 8);
    }
  }
  __syncthreads();
  *(uint4*)(smem + wofs) = kr0; *(uint4*)(smem + vofs) = vr0; *(uint4*)(smem + 17408 + wofs) = kr1; *(uint4*)(smem + 17408 + vofs) = vr1;
  __syncthreads();
  int r0 = 0, c0 = 0;
  if (MODE == 1) { r0 = min(max(na_r - 4, 0), 24); c0 = min(max(na_col - 8, 0), 48); }
  const int npairs = (ntiles + 1) >> 1;
#pragma unroll 1
  for (int ip = 0; ip < npairs; ++ip) {
    const char* stp = smem + (ip & 1) * 34816;
    const bool more = ip + 1 < npairs;
    if (more) {
      const int i0 = 2 * ip + 2;
      const int k0 = (i0 < n1) ? base1 + i0 * 64 : base2 + (i0 - n1) * 64;
      kr0 = *(const uint4*)(Kb + (size_t)(k0 + ldr) * 64 + ldc * 8);
      vr0 = *(const uint4*)(VTb + (size_t)ldr * vt_stride + k0 + ldc * 8);
      if (i0 + 1 < ntiles) {
        const int k1 = (i0 + 1 < n1) ? base1 + (i0 + 1) * 64 : base2 + (i0 + 1 - n1) * 64;
        kr1 = *(const uint4*)(Kb + (size_t)(k1 + ldr) * 64 + ldc * 8);
        vr1 = *(const uint4*)(VTb + (size_t)ldr * vt_stride + k1 + ldc * 8);
      }
    }
#pragma unroll
    for (int sub = 0; sub < 2; ++sub) {
      const int i = 2 * ip + sub;
      if (i < ntiles) {
        const char* st = stp + sub * 17408;
        bool act = true;
        int krow = 0;
        if (MODE == 1 && i < n1) { krow = na_rlo + i; act = (krow >= r0) && (krow < min(max(na_r + NQ - 1 - 4, 0), 24) + 8); }
        if (act) {
          f32x4 s[4][NQ];
    #pragma unroll
          for (int kb = 0; kb < 4; ++kb)
    #pragma unroll
            for (int qb = 0; qb < NQ; ++qb) s[kb][qb] = f32x4{0.f, 0.f, 0.f, 0.f};
          bf16x8 kf[4][2], vf[4][2];
    #pragma unroll
          for (int ks = 0; ks < 2; ++ks)
    #pragma unroll
            for (int kb = 0; kb < 4; ++kb) kf[kb][ks] = *(const bf16x8*)(st + (kb * 16 + l15) * 128 + (((ks * 4 + q4) ^ sw) << 4));
    #pragma unroll
          for (int k2 = 0; k2 < 2; ++k2)
    #pragma unroll
            for (int db = 0; db < 4; ++db) {
              const char* vrow = st + 8192 + (db * 16 + l15) * 144 + k2 * 64 + q4 * 8;
              const uint2 va = *(const uint2*)(vrow), vb = *(const uint2*)(vrow + 32);
              uint4 vv; vv.x = va.x; vv.y = va.y; vv.z = vb.x; vv.w = vb.y;
              vf[db][k2] = __builtin_bit_cast(bf16x8, vv);
            }
          __builtin_amdgcn_sched_barrier(0);
    #pragma unroll
          for (int ks = 0; ks < 2; ++ks)
    #pragma unroll
            for (int kb = 0; kb < 4; ++kb)
    #pragma unroll
              for (int qb = 0; qb < NQ; ++qb) s[kb][qb] = __builtin_amdgcn_mfma_f32_16x16x32_bf16(kf[kb][ks], qf[qb][ks], s[kb][qb], 0, 0, 0);
          __builtin_amdgcn_sched_barrier(0);
          bf16x8 pf[NQ][2];
          const float SC = 0.18033688011112042f;
    #pragma unroll
          for (int qb = 0; qb < NQ; ++qb) {
            float mx = m[qb];
            const bool biased = (MODE == 1 && i < n1);
            if (biased) {
    #pragma unroll
              for (int kb = 0; kb < 4; ++kb)
    #pragma unroll
                for (int j = 0; j < 4; ++j) {
                  const int kc = kb * 16 + q4 * 4 + j;
                  const int nr = na_r + qb, r0q = min(max(nr - 4, 0), 24);
                  const bool ok = (kc >= c0) && (kc < c0 + 16) && (krow >= r0q) && (krow < r0q + 8);
                  const float bias = rpbs[min(max(krow - nr + 7, 0), 14) * 31 + min(max(kc - na_col + 15, 0), 30)];
                  const float v = ok ? s[kb][qb][j] * SC + bias : -INFINITY;
                  s[kb][qb][j] = v;
                  mx = fmaxf(mx, v);
                }
            } else {
              float rm = s[0][qb][0];
    #pragma unroll
              for (int kb = 0; kb < 4; ++kb)
    #pragma unroll
                for (int j = 0; j < 4; ++j) rm = fmaxf(rm, s[kb][qb][j]);
              mx = fmaxf(mx, rm * SC);
            }
            if (__builtin_amdgcn_ballot_w64(mx > m[qb]) != 0ull) {
              mx = fmaxf(mx, __shfl_xor(mx, 16));
              mx = fmaxf(mx, __shfl_xor(mx, 32));
              const float alpha = __builtin_amdgcn_exp2f(m[qb] - mx);
              m[qb] = mx;
    #pragma unroll
              for (int db = 0; db < 4; ++db) o[db][qb] *= alpha;
              osum[qb] *= alpha;
            }
            mx = m[qb];
            if (biased) {
    #pragma unroll
              for (int kb = 0; kb < 4; ++kb)
    #pragma unroll
                for (int j = 0; j < 4; ++j) s[kb][qb][j] = __builtin_amdgcn_exp2f(s[kb][qb][j] - mx);
            } else {
    #pragma unroll
              for (int kb = 0; kb < 4; ++kb)
    #pragma unroll
                for (int j = 0; j < 4; ++j) s[kb][qb][j] = __builtin_amdgcn_exp2f(__builtin_fmaf(s[kb][qb][j], SC, -mx));
            }
    #pragma unroll
            for (int k2 = 0; k2 < 2; ++k2) {
              uint4 pk;
              pk.x = pack2(s[2 * k2][qb][0], s[2 * k2][qb][1]); pk.y = pack2(s[2 * k2][qb][2], s[2 * k2][qb][3]);
              pk.z = pack2(s[2 * k2 + 1][qb][0], s[2 * k2 + 1][qb][1]); pk.w = pack2(s[2 * k2 + 1][qb][2], s[2 * k2 + 1][qb][3]);
              pf[qb][k2] = __builtin_bit_cast(bf16x8, pk);
              osum[qb] = __builtin_amdgcn_mfma_f32_16x16x32_bf16(ones, pf[qb][k2], osum[qb], 0, 0, 0);
            }
          }
          __builtin_amdgcn_sched_barrier(0);
    #pragma unroll
          for (int k2 = 0; k2 < 2; ++k2)
    #pragma unroll
            for (int db = 0; db < 4; ++db)
    #pragma unroll
              for (int qb = 0; qb < NQ; ++qb) o[db][qb] = __builtin_amdgcn_mfma_f32_16x16x32_bf16(vf[db][k2], pf[qb][k2], o[db][qb], 0, 0, 0);
        }
      }
    }
    if (more) {
      char* sn = smem + ((ip + 1) & 1) * 34816;
      *(uint4*)(sn + wofs) = kr0; *(uint4*)(sn + vofs) = vr0; *(uint4*)(sn + 17408 + wofs) = kr1; *(uint4*)(sn + 17408 + vofs) = vr1;
    }
    __syncthreads();
  }
#pragma unroll
  for (int qb = 0; qb < NQ; ++qb) {
    const float inv = __builtin_amdgcn_rcpf(osum[qb][0]);
#pragma unroll
    for (int db = 0; db < 4; ++db)
      st_bf4(op + (size_t)qb * qstride_blk + db * 16 + q4 * 4, o[db][qb][0] * inv, o[db][qb][1] * inv, o[db][qb][2] * inv, o[db][qb][3] * inv);
  }
}

DI void dense_item(const P& p, int it, char* smem, bool dummy) {
  const int it0 = it;
  const int wave = tidx() >> 6, l15 = tidx() & 15;
  char* ws = p.ws;
  const u16 *Kb, *VTb;
  u16* q;
  int stride, ntiles;
  if (it < 512) {
    const int qt = it & 31, bk = it >> 5, kvh = bk & 1, b = bk >> 1;
    const int tok = NTC + b * 2048 + qt * 64 + (wave >> 2) * 32 + l15, head = kvh * 4 + (wave & 3);
    q = (u16*)(ws + O_QGA) + (size_t)tok * 512 + head * 64;
    Kb = (const u16*)(ws + O_KGA) + 1048576 + (size_t)bk * 2304 * 64; VTb = (const u16*)(ws + O_VTGA) + 1048576 + (size_t)bk * 64 * 2304;
    stride = 2304; ntiles = 36;
  } else if (it < 768) {
    it -= 512;
    const int qt = it & 3, bk = it >> 2, kvh = bk & 1, b = bk >> 1;
    const int tok = b * 256 + qt * 64 + (wave >> 2) * 32 + l15, head = kvh * 4 + (wave & 3);
    q = (u16*)(ws + O_QGA) + (size_t)tok * 512 + head * 64;
    Kb = (const u16*)(ws + O_KGA) + (size_t)bk * 256 * 64; VTb = (const u16*)(ws + O_VTGA) + (size_t)bk * 64 * 256;
    stride = 256; ntiles = 4;
  } else {
    it -= 768;
    const int tok = (it >> 3) * 256 + wave * 32 + l15, h = it & 7;
    q = (u16*)(ws + O_QNA) + (size_t)tok * 512 + h * 64;
    Kb = (const u16*)(ws + O_KNA) + (size_t)it * 256 * 64; VTb = (const u16*)(ws + O_VTNA) + (size_t)it * 64 * 256;
    stride = 256; ntiles = 4;
  }
  u16* qo = q;
  if (DUPMASK && dummy) qo = (u16*)(ws + O_XIN) + (q - (u16*)(ws + (it0 >= 768 ? O_QNA : O_QGA)));
  attn_block<2, 0>(Kb, VTb, stride, ntiles, 0, 0, ntiles, q, qo, 16 * 512, smem, 0, 0, 0, nullptr);
}
DI void na_item(const P& p, int l, int it, char* smem, bool dummy) {
  const int wave = tidx() >> 6, l15 = tidx() & 15;
  char* ws = p.ws;
  const int rq = it & 7, bh = it >> 3, h = bh & 7, b = bh >> 3;
  float* rpbs = (float*)(smem + 69632);
  __syncthreads();
  for (int e = tidx(); e < 465; e += 512) rpbs[e] = p.rpb[(size_t)(l * 8 + h) * 465 + e] * 1.4426950408889634f;
  const int r = rq * 4 + (wave >> 2) * 2, cq = (wave & 3) * 16;
  const int rlo = min(max(rq * 4 - 4, 0), 24), rhi = min(max(rq * 4 + 3 - 4, 0), 24) + 8, nband = rhi - rlo;
  const int tok = NTC + b * 2048 + r * 64 + cq + l15;
  u16* q = (u16*)(ws + O_QNA) + (size_t)tok * 512 + h * 64;
  attn_block<2, 1>((const u16*)(ws + O_KNA) + 4194304 + (size_t)bh * 2304 * 64, (const u16*)(ws + O_VTNA) + 4194304 + (size_t)bh * 64 * 2304, 2304, nband,
                   rlo * 64, 2048, nband + 4, q, (DUPMASK && dummy) ? (u16*)(ws + O_KGA) + (size_t)(tok & 8191) * 512 + h * 64 : q, 64 * 512, smem, r, cq + l15, rlo, rpbs);
}

DI void s1_tile(const P& p, int it, char* smem) {
  const int g = it / 6, m0 = (it % 6) * 256;
  const int tid = tidx(), lane = tid & 63, wave = tid >> 6, wr = wave >> 2, wc = wave & 3, fr = lane & 15, fq = lane >> 4;
  f32x4 acc8[2][2][4][2];
  ZERO_ACC8(acc8);
  {
    unsigned v0, v1, w0, w1;
    voff_nat(256, v0, v1);
    voff_perm(256, w0, w1);
    gemm256((LAS unsigned char*)smem, (const char*)(p.ws + O_UC) + ((size_t)g * 1536 + m0) * 512, (size_t)128 * 512, v0, v1, (const char*)(p.ws + O_WST) + (size_t)g * 256 * 512, (size_t)128 * 512, w0, w1,
            4, acc8);
  }
  u16* S = (u16*)(p.ws + O_SB) + (size_t)g * 1536 * 256;
  int rb = (m0 + wr * 64 + fr) * 256 + wc * 32 + fq * 8;
  asm volatile("" : "+v"(rb));
#pragma unroll
  for (int ai = 0; ai < 2; ++ai)
#pragma unroll
    for (int m = 0; m < 4; ++m)
#pragma unroll
      for (int bj = 0; bj < 2; ++bj) st_bf8(S + (size_t)(rb + (ai * 128 + m * 16) * 256 + bj * 128), acc8[ai][bj][m][0], acc8[ai][bj][m][1]);
}

DI void scan_item(const P& p, int l, int it) {
  int sq, gq;
  if (it < 64) { sq = 32 + (it >> 3); gq = it & 7; } else { sq = (it - 64) >> 3; gq = (it - 64) & 7; }
  const int tid = tidx(), g = gq * 4 + (tid >> 7), d = (tid >> 6) & 1, pp = tid & 63;
  const int nc = sq < 32 ? 16 : 128, row0 = sq < 32 ? sq * 16 : 512 + (sq - 32) * 128;
  const float2 lt = ((const float2*)(p.ws + O_LAMT))[(d * 32 + g) * 64 + pp];
  float xr = 0.f, xi = 0.f;
  if (sq >= 32) {
    const int si = ((((sq - 32) * 2 + l) * 2 + d) * 32 + g) * 64 + pp;
    xr = p.sre[si]; xi = p.sim[si];
  }
  const unsigned* S = (const unsigned*)(p.ws + O_SB) + ((size_t)g * 1536 + row0) * 128 + d * 64 + pp;
  unsigned* X = (unsigned*)(p.ws + O_XIN) + ((size_t)g * 1536 + row0) * 128 + d * 64 + pp;
  const int c0 = d ? nc - 1 : 0, step = d ? -1 : 1;
  X[(size_t)c0 * 128] = pack2(xr, xi);
  for (int cb = 0; cb < nc; cb += 16) {
    unsigned sv[16];
#pragma unroll
    for (int i = 0; i < 16; ++i) sv[i] = S[(size_t)(c0 + (cb + i) * step) * 128];
#pragma unroll
    for (int i = 0; i < 16; ++i) {
      const int c = c0 + (cb + i) * step;
      const float nr = lt.x * xr - lt.y * xi + bflo(sv[i]), ni = lt.x * xi + lt.y * xr + bfhi(sv[i]);
      xr = nr; xi = ni;
      const int cn = c + step;
      if (cn >= 0 && cn < nc) X[(size_t)cn * 128] = pack2(xr, xi);
    }
  }
  if (sq < 32) {
    const size_t oi = ((((size_t)sq * 2 + l) * 2 + d) * 32 + g) * 64 + pp;
    p.out[OUT_SRE + oi] = xr; p.out[OUT_SIM + oi] = xi;
  }
}

DI void s3_tile(const P& p, int l, int it, char* smem) {
  const int g = it / 6, m0 = (it % 6) * 256;
  const int tid = tidx(), lane = tid & 63, wave = tid >> 6, wr = wave >> 2, wc = wave & 3, fr = lane & 15, fq = lane >> 4;
  const u16* A1 = (const u16*)(p.ws + O_UC) + (size_t)g * 1536 * 256;
  f32x4 acc8[2][2][4][2];
  ZERO_ACC8(acc8);
  {
    unsigned va0, va1, vb0, vb1;
    voff_nat(256, va0, va1);
    voff_perm(512, vb0, vb1);
    const char* B = (const char*)(p.ws + O_WOUT) + (size_t)g * 256 * 1024;
    gemm256((LAS unsigned char*)smem, (const char*)A1 + (size_t)m0 * 512, (size_t)128 * 512, va0, va1, B, (size_t)128 * 1024, vb0, vb1, 4, acc8);
    gemm256((LAS unsigned char*)smem, (const char*)(p.ws + O_XIN) + ((size_t)g * 1536 + m0) * 512, (size_t)128 * 512, va0, va1, B + 512, (size_t)128 * 1024, vb0, vb1, 4, acc8);
  }
  u16* G = (u16*)(p.ws + O_SB);
  const float4 d0 = *(const float4*)(p.ssm_d + l * 512 + g * 16 + (fq & 1) * 8), d1 = *(const float4*)(p.ssm_d + l * 512 + g * 16 + (fq & 1) * 8 + 4);
  int rbase = m0 + wr * 64 + fr;
  asm volatile("" : "+v"(rbase));
#pragma unroll
  for (int ai = 0; ai < 2; ++ai)
#pragma unroll
    for (int m = 0; m < 4; ++m) {
#pragma unroll
      for (int bj = 0; bj < 2; ++bj) {
        const int row = rbase + ai * 128 + m * 16, nn = bj * 128 + wc * 32 + fq * 8, t = nn >> 4;
        const uint4 uv = *(const uint4*)(A1 + (size_t)row * 256 + nn);
        f32x4 y0 = acc8[ai][bj][m][0], y1 = acc8[ai][bj][m][1];
        y0[0] += d0.x * bflo(uv.x); y0[1] += d0.y * bfhi(uv.x); y0[2] += d0.z * bflo(uv.y); y0[3] += d0.w * bfhi(uv.y);
        y1[0] += d1.x * bflo(uv.z); y1[1] += d1.y * bfhi(uv.z); y1[2] += d1.z * bflo(uv.w); y1[3] += d1.w * bfhi(uv.w);
#pragma unroll
        for (int j = 0; j < 4; ++j) {
          const float x = y0[j], z = y1[j];
          y0[j] = 0.5f * x * (1.f + tanhf(0.7978845608028654f * (x + 0.044715f * x * x * x)));
          y1[j] = 0.5f * z * (1.f + tanhf(0.7978845608028654f * (z + 0.044715f * z * z * z)));
        }
        st_bf8(G + (size_t)(row * 16 + t) * 512 + g * 16 + (fq & 1) * 8, y0, y1);
      }
      if (m == 3) asm volatile("" ::: "memory");
    }
}

DI void glu_tile(const P& p, int it, char* smem) {
  const int m0 = (it >> 1) * 256, pn = it & 1;
  const int tid = tidx(), lane = tid & 63, wave = tid >> 6, wr = wave >> 2, wc = wave & 3, fr = lane & 15, fq = lane >> 4;
  const u16* A = (const u16*)(p.ws + O_SB);
  f32x4 acc8[2][2][4][2];
  ZERO_ACC8(acc8);
  {
    unsigned v0, v1, w0, w1;
    voff_nat(512, v0, v1);
    voff_perm(512, w0, w1);
    gemm256((LAS unsigned char*)smem, (const char*)A + (size_t)m0 * 1024, (size_t)128 * 1024, v0, v1, (const char*)(p.ws + WT_GLU) + (size_t)pn * 256 * 1024, (size_t)128 * 1024, w0, w1, 8, acc8);
  }
  u16* Y = (u16*)(p.ws + O_UC);
  int rb = (m0 + wr * 64 + fr) * 512 + pn * 256 + wc * 32 + fq * 8;
  asm volatile("" : "+v"(rb));
#pragma unroll
  for (int ai = 0; ai < 2; ++ai)
#pragma unroll
    for (int m = 0; m < 4; ++m) {
#pragma unroll
      for (int bj = 0; bj < 2; ++bj) {
        const size_t o = (size_t)(rb + (ai * 128 + m * 16) * 512 + bj * 128);
        const uint4 gv = *(const uint4*)(A + o);
        f32x4 y0, y1;
        y0[0] = bflo(gv.x) * sigmoidf_(acc8[ai][bj][m][0][0]); y0[1] = bfhi(gv.x) * sigmoidf_(acc8[ai][bj][m][0][1]);
        y0[2] = bflo(gv.y) * sigmoidf_(acc8[ai][bj][m][0][2]); y0[3] = bfhi(gv.y) * sigmoidf_(acc8[ai][bj][m][0][3]);
        y1[0] = bflo(gv.z) * sigmoidf_(acc8[ai][bj][m][1][0]); y1[1] = bfhi(gv.z) * sigmoidf_(acc8[ai][bj][m][1][1]);
        y1[2] = bflo(gv.w) * sigmoidf_(acc8[ai][bj][m][1][2]); y1[3] = bfhi(gv.w) * sigmoidf_(acc8[ai][bj][m][1][3]);
        st_bf8(Y + o, y0, y1);
      }
      if (m == 3) asm volatile("" ::: "memory");
    }
}

DI void merge_tile(const P& p, int it, char* smem) {
  const int pm = it >> 2, pn = it & 3, m0 = pm * 256;
  const int tid = tidx(), lane = tid & 63, wave = tid >> 6, wr = wave >> 2, wc = wave & 3, fr = lane & 15, fq = lane >> 4;
  unsigned char* T = (unsigned char*)(p.ws + O_SB) + (size_t)blockIdx.x * 196608;
  f32x4 acc8[2][2][4][2];
#pragma unroll 1
  for (int br = 0; br < 3; ++br) {
    ZERO_ACC8(acc8);
    {
      const char* Hb = (const char*)(p.ws + O_H) + (size_t)m0 * 2048;
      const char* Wg = (const char*)(p.ws + WT_IN) + (size_t)(2816 + br * 1024 + pn * 256) * 2048;
      const bool tob = (br == 2);
      gemm256c((LAS unsigned char*)smem, Hb, (size_t)128 * 2048, Wg, (size_t)128 * 2048, 1024, 16, tob ? (const char*)(p.ws + O_QGA) + (size_t)m0 * 1024 : Hb, tob ? (size_t)128 * 1024 : (size_t)128 * 2048,
               tob ? (const char*)(p.ws + WT_BR) + (size_t)(pn * 256) * 1024 : Wg + (size_t)1024 * 2048, tob ? (size_t)128 * 1024 : (size_t)128 * 2048, tob ? 512 : 1024, true, br == 0, false, acc8);
    }
    int tb = (br * 8 + wave) * 8192 + lane * 4;
    asm volatile("" : "+v"(tb));
#pragma unroll
    for (int ai = 0; ai < 2; ++ai)
#pragma unroll
      for (int m = 0; m < 4; ++m)
#pragma unroll
        for (int bj = 0; bj < 2; ++bj)
#pragma unroll
          for (int n = 0; n < 2; ++n) {
            unsigned q = 0;
#pragma unroll
            for (int j = 0; j < 4; ++j) {
              const float g = fmaxf(255.f * __builtin_amdgcn_rcpf(1.f + __builtin_amdgcn_exp2f(acc8[ai][bj][m][n][j] * -1.4426950408889634f)) + 0.5f, 1.f);
              q = __builtin_amdgcn_cvt_pk_u8_f32(g, j, q);
            }
            *(unsigned*)(T + tb + (((ai * 4 + m) * 2 + bj) * 2 + n) * 256) = q;
          }
  }
  ZERO_ACC8(acc8);
#pragma unroll 1
  for (int br = 0; br < 3; ++br) {
    {
      const int nb = br < 2 ? br + 1 : 2;
      const char* Y = p.ws + (br == 0 ? O_QGA : br == 1 ? O_UC : O_QNA);
      const char* Yn = p.ws + (nb == 1 ? O_UC : O_QNA);
      gemm256c((LAS unsigned char*)smem, Y + (size_t)m0 * 1024, (size_t)128 * 1024, (const char*)(p.ws + WT_BR) + ((size_t)br * 1024 + pn * 256) * 1024, (size_t)128 * 1024, 512, 8,
               Yn + (size_t)m0 * 1024, (size_t)128 * 1024, (const char*)(p.ws + WT_BR) + ((size_t)nb * 1024 + pn * 256) * 1024, (size_t)128 * 1024, 512, br < 2, false, br == 2, acc8);
    }
    int tb = (br * 8 + wave) * 8192 + lane * 4;
    asm volatile("" : "+v"(tb));
#pragma unroll
    for (int ai = 0; ai < 2; ++ai)
#pragma unroll
      for (int m = 0; m < 4; ++m)
#pragma unroll
        for (int bj = 0; bj < 2; ++bj)
#pragma unroll
          for (int n = 0; n < 2; ++n) {
            const int off = tb + (((ai * 4 + m) * 2 + bj) * 2 + n) * 256;
            const unsigned qa = *(const unsigned*)(T + off);
            const unsigned qb = (br < 2) ? *(const unsigned*)(T + off + 65536) : 0xffffffffu;
#pragma unroll
            for (int j = 0; j < 4; ++j) {
              const float ga = (float)((qa >> (8 * j)) & 255u), gb = (float)((qb >> (8 * j)) & 255u);
              acc8[ai][bj][m][n][j] *= ga * __builtin_amdgcn_rcpf(gb);
            }
            if (n == 1 && bj == 1 && m == 3) asm volatile("" ::: "memory");
          }
  }
  u16* M = (u16*)(p.ws + O_MG);
  int rb = (m0 + wr * 64 + fr) * 1024 + pn * 256 + wc * 32 + fq * 8;
  asm volatile("" : "+v"(rb));
#pragma unroll
  for (int ai = 0; ai < 2; ++ai)
#pragma unroll
    for (int m = 0; m < 4; ++m)
#pragma unroll
      for (int bj = 0; bj < 2; ++bj) st_bf8(M + (size_t)(rb + (ai * 128 + m * 16) * 1024 + bj * 128), acc8[ai][bj][m][0], acc8[ai][bj][m][1]);
}

template <int K>
DI void plain_tile(const u16* A, const u16* W, u16* O, int m0, int pn, char* smem) {
  const int tid = tidx(), lane = tid & 63, wave = tid >> 6, wr = wave >> 2, wc = wave & 3, fr = lane & 15, fq = lane >> 4;
  f32x4 acc8[2][2][4][2];
  ZERO_ACC8(acc8);
  {
    unsigned v0, v1, w0, w1;
    voff_nat(K, v0, v1);
    voff_perm(K, w0, w1);
    gemm256((LAS unsigned char*)smem, (const char*)A + (size_t)m0 * K * 2, (size_t)128 * K * 2, v0, v1, (const char*)W + (size_t)pn * 256 * K * 2, (size_t)128 * K * 2, w0, w1, K / 64, acc8);
  }
  int rb = (m0 + wr * 64 + fr) * 1024 + pn * 256 + wc * 32 + fq * 8;
  asm volatile("" : "+v"(rb));
#pragma unroll
  for (int ai = 0; ai < 2; ++ai)
#pragma unroll
    for (int m = 0; m < 4; ++m)
#pragma unroll
      for (int bj = 0; bj < 2; ++bj) st_bf8(O + (size_t)(rb + (ai * 128 + m * 16) * 1024 + bj * 128), acc8[ai][bj][m][0], acc8[ai][bj][m][1]);
}
template <int K>
DI void plain_phase(const u16* A, const u16* W, u16* O, int vb, int G, char* smem) {
  for (int it = vb; it < 384; it += G) plain_tile<K>(A, W, O, (it >> 2) * 256, it & 3, smem);
}

DI void up_tile(const P& p, int l, int it, char* smem) {
  const int mt = it / 22, pn = it % 22, m0 = mt * 256, j0 = pn * 128;
  const int tid = tidx(), lane = tid & 63, wave = tid >> 6, wr = wave >> 2, wc = wave & 3, fr = lane & 15, fq = lane >> 4;
  f32x4 acc8[2][2][4][2];
  ZERO_ACC8(acc8);
  {
    unsigned v0, v1, w0, w1;
    voff_nat(1024, v0, v1);
    voff_perm(1024, w0, w1);
    gemm256((LAS unsigned char*)smem, (const char*)(p.ws + O_H) + (size_t)m0 * 2048, (size_t)128 * 2048, v0, v1, (const char*)(p.ws + (l ? WT_UP2 : WT_UP)) + (size_t)j0 * 2048, (size_t)2816 * 2048, w0, w1,
            16, acc8);
  }
  u16* E = (u16*)smem;
#pragma unroll
  for (int ai = 0; ai < 2; ++ai)
#pragma unroll
    for (int m = 0; m < 4; ++m)
#pragma unroll
      for (int bj = 0; bj < 2; ++bj) st_bf8(E + (ai * 128 + wr * 64 + m * 16 + fr) * 264 + bj * 128 + wc * 32 + fq * 8, acc8[ai][bj][m][0], acc8[ai][bj][m][1]);
  __syncthreads();
  {
    const int cg = tid & 15, tg = tid >> 4, ja = j0 + cg * 8;
    const bool lat = mt >= 32;
    const int ti = lat ? ((mt - 32) & 7) : 0;
    const float* cw = p.conv_w + (size_t)l * 3 * 5632;
    const float* cb = p.conv_b + (size_t)l * 5632;
    float wa[3][8], wg[3][8], ba[8], bg[8];
#pragma unroll
    for (int dt = 0; dt < 3; ++dt) {
      const float4 a0 = *(const float4*)(cw + dt * 5632 + ja), a1 = *(const float4*)(cw + dt * 5632 + ja + 4);
      const float4 g0 = *(const float4*)(cw + dt * 5632 + 2816 + ja), g1 = *(const float4*)(cw + dt * 5632 + 2816 + ja + 4);
      wa[dt][0] = a0.x; wa[dt][1] = a0.y; wa[dt][2] = a0.z; wa[dt][3] = a0.w; wa[dt][4] = a1.x; wa[dt][5] = a1.y; wa[dt][6] = a1.z; wa[dt][7] = a1.w;
      wg[dt][0] = g0.x; wg[dt][1] = g0.y; wg[dt][2] = g0.z; wg[dt][3] = g0.w; wg[dt][4] = g1.x; wg[dt][5] = g1.y; wg[dt][6] = g1.z; wg[dt][7] = g1.w;
    }
    {
      const float4 a0 = *(const float4*)(cb + ja), a1 = *(const float4*)(cb + ja + 4), g0 = *(const float4*)(cb + 2816 + ja), g1 = *(const float4*)(cb + 2816 + ja + 4);
      ba[0] = a0.x; ba[1] = a0.y; ba[2] = a0.z; ba[3] = a0.w; ba[4] = a1.x; ba[5] = a1.y; ba[6] = a1.z; ba[7] = a1.w;
      bg[0] = g0.x; bg[1] = g0.y; bg[2] = g0.z; bg[3] = g0.w; bg[4] = g1.x; bg[5] = g1.y; bg[6] = g1.z; bg[7] = g1.w;
    }
    float ra[3][8], rg[3][8];
    auto ldrow = [&](int tt, float (&xa)[8], float (&xg)[8]) {
      if (tt >= 0 && tt < 256) {
        const uint4 ua = *(const uint4*)(E + tt * 264 + cg * 8);
        const uint4 ug = *(const uint4*)(E + tt * 264 + 128 + cg * 8);
        xa[0] = bflo(ua.x); xa[1] = bfhi(ua.x); xa[2] = bflo(ua.y); xa[3] = bfhi(ua.y); xa[4] = bflo(ua.z); xa[5] = bfhi(ua.z); xa[6] = bflo(ua.w); xa[7] = bfhi(ua.w);
        xg[0] = bflo(ug.x); xg[1] = bfhi(ug.x); xg[2] = bflo(ug.y); xg[3] = bfhi(ug.y); xg[4] = bflo(ug.z); xg[5] = bfhi(ug.z); xg[6] = bflo(ug.w); xg[7] = bfhi(ug.w);
      } else {
#pragma unroll
        for (int i = 0; i < 8; ++i) { xa[i] = 0.f; xg[i] = 0.f; }
      }
    };
    const int t0 = tg * 8;
    ldrow(t0 - 1, ra[0], rg[0]);
    ldrow(t0, ra[1], rg[1]);
    u16* o = (u16*)(p.ws + O_ACT) + (size_t)(m0 + t0) * 2816 + ja;
#pragma unroll
    for (int i = 0; i < 8; ++i) {
      const int t = t0 + i;
      ldrow(t + 1, ra[(i + 2) % 3], rg[(i + 2) % 3]);
      const bool defer = lat && ((t == 0 && ti > 0) || (t == 255 && ti < 7));
      if (!defer) {
        float r[8];
#pragma unroll
        for (int c = 0; c < 8; ++c) {
          const float av = ba[c] + wa[0][c] * ra[i % 3][c] + wa[1][c] * ra[(i + 1) % 3][c] + wa[2][c] * ra[(i + 2) % 3][c];
          const float gv = bg[c] + wg[0][c] * rg[i % 3][c] + wg[1][c] * rg[(i + 1) % 3][c] + wg[2][c] * rg[(i + 2) % 3][c];
          r[c] = gv * __builtin_amdgcn_rcpf(1.f + __expf(-gv)) * av;
        }
        uint4 ov; ov.x = pack2(r[0], r[1]); ov.y = pack2(r[2], r[3]); ov.z = pack2(r[4], r[5]); ov.w = pack2(r[6], r[7]);
        *(uint4*)(o + (size_t)i * 2816) = ov;
      }
    }
    if (lat && (tg == 0 || tg == 31)) {
      u16* sd = (u16*)(p.ws + O_USIDE) + ((size_t)(mt - 32) * 4 + (tg ? 2 : 0)) * 5632;
      const int tr = tg ? 254 : 0;
#pragma unroll
      for (int w = 0; w < 2; ++w) {
        *(uint4*)(sd + (size_t)w * 5632 + ja) = *(const uint4*)(E + (tr + w) * 264 + cg * 8);
        *(uint4*)(sd + (size_t)w * 5632 + 2816 + ja) = *(const uint4*)(E + (tr + w) * 264 + 128 + cg * 8);
      }
    }
  }
  __syncthreads();
}

DI void up_fixup_tile(const P& p, int l, int lt) {
  const float* cw = p.conv_w + (size_t)l * 3 * 5632;
  const float* cb = p.conv_b + (size_t)l * 5632;
  const u16* sd = (const u16*)(p.ws + O_USIDE);
  const int ti = lt & 7;
  for (int e = tidx(); e < 2 * 2816; e += 512) {
    const int side = e >= 2816 ? 1 : 0, j = e - side * 2816;
    if ((side == 0 && ti == 0) || (side == 1 && ti == 7)) continue;
    const u16 *rm, *r0, *rp;
    if (side == 0) { rm = sd + ((size_t)(lt - 1) * 4 + 3) * 5632; r0 = sd + ((size_t)lt * 4 + 0) * 5632; rp = sd + ((size_t)lt * 4 + 1) * 5632; }
    else { rm = sd + ((size_t)lt * 4 + 2) * 5632; r0 = sd + ((size_t)lt * 4 + 3) * 5632; rp = sd + ((size_t)(lt + 1) * 4 + 0) * 5632; }
    const float a = cw[j] * bf2f(rm[j]) + cw[5632 + j] * bf2f(r0[j]) + cw[2 * 5632 + j] * bf2f(rp[j]) + cb[j];
    const float g = cw[2816 + j] * bf2f(rm[2816 + j]) + cw[5632 + 2816 + j] * bf2f(r0[2816 + j]) + cw[2 * 5632 + 2816 + j] * bf2f(rp[2816 + j]) + cb[2816 + j];
    const int tk = NTC + lt * 256 + (side ? 255 : 0);
    ((u16*)(p.ws + O_ACT))[(size_t)tk * 2816 + j] = f2bf(g * __builtin_amdgcn_rcpf(1.f + __expf(-g)) * a);
  }
  asm volatile("s_waitcnt vmcnt(0)" ::: "memory");
  __syncthreads();
}

#define XB_TMO      128
#define XB_XCNT(j)  (256  + 64 * (j))
#define XB_XSUB(j)  (1280 + 64 * (j))
#define XB_XGEN(j)  (2304 + 64 * (j))
#define XB_TOP      3328
#define XB_TOPGEN   3392
#define XCD_BAR_WORDS 3456
#define XB_SPIN_CAP (1u << 18)
DI unsigned xb_ld(unsigned* p) { return __hip_atomic_load(p, __ATOMIC_RELAXED, __HIP_MEMORY_SCOPE_AGENT); }
DI unsigned xb_add(unsigned* p, unsigned v) { return __hip_atomic_fetch_add(p, v, __ATOMIC_RELAXED, __HIP_MEMORY_SCOPE_AGENT); }
DI unsigned xb_xcc_id() { return (unsigned)__builtin_amdgcn_s_getreg((3 << 11) | 20) & 0xFu; }
#define XB_SPIN(cond, bar) do { unsigned _sp = 0; while (cond) { __builtin_amdgcn_s_sleep(1); \
    if ((++_sp & 255u) == 0u) { if (xb_ld(&(bar)[XB_TMO])) break; if (_sp > XB_SPIN_CAP) { atomicAdd(&(bar)[XB_TMO], 1u); break; } } } } while (0)
struct XcdBarrier { unsigned* bar; unsigned x; volatile LAS unsigned* st; };
DI XcdBarrier xcd_barrier_post(unsigned* bar, volatile LAS unsigned* st) {
  XcdBarrier b; b.bar = bar; b.x = xb_xcc_id(); b.st = st;
  if (threadIdx.x == 0) (void)xb_add(&bar[XB_XCNT(b.x)], 1u);
  return b;
}
DI void xcd_barrier_complete(unsigned* bar, unsigned x, unsigned& nloc, unsigned& nx) {
  const unsigned G = gridDim.x * gridDim.y * gridDim.z;
  unsigned sum, cnt, mine, sp = 0u;
  for (;;) {
    sum = 0u; cnt = 0u; mine = 0u;
#pragma unroll
    for (unsigned j = 0; j < 16; ++j) { const unsigned c = xb_ld(&bar[XB_XCNT(j)]); sum += c; cnt += (c > 0u) ? 1u : 0u; mine = (j == x) ? c : mine; }
    if (sum == G) break;
    __builtin_amdgcn_s_sleep(1);
    if ((++sp & 255u) == 0u) { if (xb_ld(&bar[XB_TMO])) break; if (sp > XB_SPIN_CAP) { atomicAdd(&bar[XB_TMO], 1u); break; } }
  }
  nloc = mine > 0u ? mine : 1u; nx = cnt > 0u ? cnt : 1u;
}
DI void xcd_barrier(const XcdBarrier& b) {
  asm volatile("s_waitcnt vmcnt(0)" ::: "memory");
  __syncthreads();
  if (threadIdx.x == 0) {
    unsigned* bar = b.bar;
    __builtin_amdgcn_s_waitcnt(0);
    unsigned nloc = b.st[0], nx = b.st[1];
    if (nloc == 0u) { xcd_barrier_complete(bar, b.x, nloc, nx); b.st[0] = nloc; b.st[1] = nx; }
    const unsigned old = xb_add(&bar[XB_XSUB(b.x)], 1u);
    const unsigned gen = old / nloc;
    if (old + 1u == (gen + 1u) * nloc) {
      __builtin_amdgcn_fence(__ATOMIC_RELEASE, "agent");
      asm volatile("s_waitcnt vmcnt(0)" ::: "memory");
      const unsigned og = xb_add(&bar[XB_TOP], 1u);
      const unsigned tg = og / nx;
      if (og + 1u == (tg + 1u) * nx) xb_add(&bar[XB_TOPGEN], 1u);
      else XB_SPIN(xb_ld(&bar[XB_TOPGEN]) == tg, bar);
      __builtin_amdgcn_fence(__ATOMIC_ACQUIRE, "agent");
      xb_add(&bar[XB_XGEN(b.x)], 1u);
      asm volatile("s_waitcnt vmcnt(0)" ::: "memory");
    } else {
      XB_SPIN(xb_ld(&bar[XB_XGEN(b.x)]) == gen, bar);
      __builtin_amdgcn_fence(__ATOMIC_ACQUIRE, "agent");
      asm volatile("s_waitcnt vmcnt(0)" ::: "memory");
    }
  }
  __syncthreads();
}

#define PFIELDS(X) X(x_prompt) X(x_sample) X(c) X(cgk) X(cgv) X(cnk) X(cnv) X(sre) X(sim) X(c_ctx) X(w_mod) X(b_mod) X(norm_g) X(w_in) X(qk_g) X(rpb) X(lam_re) \
  X(lam_im) X(log_step) X(b_re) X(b_im) X(c_re) X(c_im) X(ssm_d) X(w_glu) X(w_br_a) X(w_br_b) X(w_br_c) X(w_out) X(w_up) X(conv_w) X(conv_b) X(w_down)
DI void p_store(const P& p, volatile LAS unsigned* t) {
  int i = 0;
#define X(f) { const unsigned long long v_ = (unsigned long long)p.f; t[i] = (unsigned)v_; t[i + 1] = (unsigned)(v_ >> 32); i += 2; }
  PFIELDS(X)
#undef X
  { const unsigned long long v_ = (unsigned long long)p.out; t[i] = (unsigned)v_; t[i + 1] = (unsigned)(v_ >> 32); i += 2; }
  { const unsigned long long v_ = (unsigned long long)p.ws; t[i] = (unsigned)v_; t[i + 1] = (unsigned)(v_ >> 32); }
}
DI unsigned long long p_ld(volatile LAS unsigned* t, int i) {
  const unsigned lo = __builtin_amdgcn_readfirstlane(t[i]), hi = __builtin_amdgcn_readfirstlane(t[i + 1]);
  return ((unsigned long long)hi << 32) | lo;
}
DI P p_load(volatile LAS unsigned* t) {
  int i = 0;
#define X(f) const float* f##_ = (const float*)(const __attribute__((address_space(1))) float*)p_ld(t, i); i += 2;
  PFIELDS(X)
#undef X
  float* out_ = (float*)(__attribute__((address_space(1))) float*)p_ld(t, i); i += 2;
  char* ws_ = (char*)(__attribute__((address_space(1))) char*)p_ld(t, i);
  return P{
#define X(f) f##_,
  PFIELDS(X)
#undef X
  out_, ws_};
}
DI void run_phase(int ph, char* smem, const XcdBarrier& xb) {
  unsigned taddr = (unsigned)(SMEM_BYTES - 16 - 320);
  asm volatile("" : "+v"(taddr));
  const P p = p_load((volatile LAS unsigned*)(unsigned long long)taddr);
  const int G = gridDim.x, vb = vblock();
  char* ws = p.ws;
  if (ph == 0) { prep_layer0(p, smem); rope_table(p); if (DUPMASK & 0x1000) { xcd_barrier(xb); prep_layer0(p, smem); rope_table(p); } return; }
  if (ph == 1) { row_phase(p, 1 | 4, 0, 0, 0, nullptr, 0, 0, 0, 1); if (DUPMASK & 0x2000) { xcd_barrier(xb); row_phase(p, 1 | 4, 0, 0, 0, nullptr, 0, 0, 0, 1); } return; }
  const int l = (ph - 2) / 11, s = (ph - 2) % 11;
  const int nrep = ((DUPMASK >> s) & 1) ? 2 : 1;
  for (int rep = 0; rep < nrep; ++rep) {
    const bool dummy = (rep + 1 < nrep);
    if (rep > 0) xcd_barrier(xb);
    switch (s) {
      case 0: for (int it = vb; it < 96 * 11; it += G) inproj_tile(p, l, it, smem); break;
      case 1: for (int it = vb; it < 1024 + 192; it += G) { if (it < 1024) dense_item(p, it, smem, dummy); else s1_tile(p, it - 1024, smem); } break;
      case 2: for (int it = vb; it < 320 + 512; it += G) { if (it < 320) { if (!(DUPMASK & 0x10000) || !dummy) scan_item(p, l, it); } else if (!(DUPMASK & 0x20000) || !dummy) na_item(p, l, it - 320, smem, dummy); } break;
      case 3: for (int it = vb; it < 192; it += G) s3_tile(p, l, it, smem); break;
      case 4: for (int it = vb; it < 192; it += G) glu_tile(p, it, smem); break;
      case 5: for (int it = vb; it < 384; it += G) merge_tile(p, it, smem);
              if (l == 0 && G == 256 && vb >= 128) for (int ci = NCONV_A + vb - 128; ci < NCONV; ci += 128) conv_item(p, 1, ci, smem);
              if (l == 0 && G != 256) for (int ci = NCONV_A + vb; ci < NCONV; ci += G) conv_item(p, 1, ci, smem);
              break;
      case 6: plain_phase<1024>((const u16*)(ws + O_MG), (const u16*)(ws + WT_OUT), (u16*)(ws + O_OB), vb, G, smem);
              if (l == 0) { if (G == 256) { if (vb >= 128 && vb < 160) ssm_tables(p, 1, vb - 128, smem); } else for (int ci = vb; ci < 32; ci += G) ssm_tables(p, 1, ci, smem); }
              break;
      case 7: row_phase(p, (l == 0 ? 1 : 0) | 2 | 4, l, 1, 2, (const u16*)(ws + O_OB), l, 2, 3, 4); break;
      case 8: for (int it = vb; it < 96 * 22; it += G) up_tile(p, l, it, smem);
              if (l == 0 && G == 256 && vb >= 64) for (int ci = vb - 64; ci < NCONV_A; ci += 192) conv_item(p, 1, ci, smem);
              if (l == 0 && G != 256) for (int ci = vb; ci < NCONV_A; ci += G) conv_item(p, 1, ci, smem);
              break;
      case 9:
        for (int it = vb; it < 384; it += G) {
          if ((it >> 2) >= 32) up_fixup_tile(p, l, (it >> 2) - 32);
          plain_tile<2816>((const u16*)(ws + O_ACT), (const u16*)(ws + (l ? WT_DN2 : WT_DN)), (u16*)(ws + O_F), (it >> 2) * 256, it & 3, smem);
        }
        break;
      case 10:
        if (l == 0) { row_phase(p, 2 | 4, 0, 3, 5, (const u16*)(ws + O_F), 1, 0, 0, 1); cache_convert(p, 1); }
        else row_phase(p, 2, 1, 3, 5, (const u16*)(ws + O_F), 0, 0, 0, 0);
        break;
    }
  }
}

__global__ void __launch_bounds__(512) mega(P p, int ph_lo, int ph_hi) {
  extern __shared__ __attribute__((aligned(16))) char smem[];
  volatile LAS unsigned* st = (volatile LAS unsigned*)((LAS char*)smem + (SMEM_BYTES - 16));
  if (threadIdx.x < 4) st[threadIdx.x] = 0u;
  if (threadIdx.x == 0) p_store(p, (volatile LAS unsigned*)((LAS char*)smem + (SMEM_BYTES - 16 - 320)));
  __syncthreads();
  const XcdBarrier xb = xcd_barrier_post((unsigned*)(p.ws + O_BAR), st);
  for (int ph = ph_lo; ph < ph_hi; ++ph) {
    run_phase(ph, smem, xb);
    if (ph + 1 < ph_hi) {
      if (ph == ph_lo) cg::this_grid().sync();
      else xcd_barrier(xb);
    }
  }
}

extern "C" void kernel_launch(void* const* d_in, const int* in_sizes, int n_in, void* d_out, int out_size, void* d_ws, size_t ws_size, hipStream_t stream) {
  P p{};
  const float** pp = (const float**)&p;
  for (int i = 0; i < 33; ++i) pp[i] = (const float*)d_in[i];
  p.out = (float*)d_out;
  p.ws = (char*)d_ws;
  static int grid_blocks = 0;
  if (!grid_blocks) {
    hipFuncSetAttribute((const void*)mega, hipFuncAttributeMaxDynamicSharedMemorySize, SMEM_BYTES);
    int dev = 0, cus = 0, per_cu = 0;
    hipGetDevice(&dev);
    hipDeviceGetAttribute(&cus, hipDeviceAttributeMultiprocessorCount, dev);
    hipOccupancyMaxActiveBlocksPerMultiprocessor(&per_cu, mega, 512, SMEM_BYTES);
    if (per_cu < 1) per_cu = 1;
    if (per_cu > 1) per_cu = 1;
    grid_blocks = cus * per_cu;
  }
  hipMemsetAsync((char*)d_ws + O_BAR, 0, XCD_BAR_WORDS * 4, stream);
#if SINGLE_LAUNCH
  int lo = 0, hi = NPHASE;
  void* args[] = {&p, &lo, &hi};
  hipError_t e = hipLaunchCooperativeKernel((void*)mega, dim3(grid_blocks), dim3(512), args, SMEM_BYTES, stream);
  if (e != hipSuccess) fprintf(stderr, "cooperative launch failed: %s (grid %d)\n", hipGetErrorString(e), grid_blocks);
#else
  for (int ph = 0; ph < NPHASE; ++ph) hipLaunchKernelGGL(mega, dim3(grid_blocks), dim3(512), SMEM_BYTES, stream, p, ph, ph + 1);
#endif
}
```
